# Optimizing an MI355X kernel written in HIP

```python
import math
import jax, jax.numpy as jnp
from jax import lax
import numpy as np

D_MODEL = 2048
BATCH = 2
SEQ = 4096
DEPTH = 2
DEC_BATCH = 32
DEC_SEQ = 64
PAST_LEN = 2048

CHUNK = 64
W_LRU = 1024
LRU_BLOCKS = 16
LRU_CONV = 4
LRU_C = 8.0
W_CONF = 1024
CONF_CONV = 31
N_HEADS = 8
N_KV = 2
HEAD_DIM = 128
ROT_DIM = HEAD_DIM // 4
N_IDX_HEADS = 8
IDX_DIM = 64
IDX_ROT = IDX_DIM // 4
TOPK_ATT = 256
ROPE_THETA = 500000.0
Q_BLOCK = 128
W_POOL = 1024
POOL_WINDOWS = (2, 4, 8, 16)
POOL_GROUPS = 4
POOL_GW = W_POOL // POOL_GROUPS
POOL_BUF = 15
N_BRANCH = 4
W_BRANCH = 1024
PEER_HEADS = 8
PEER_NKEYS = 128
PEER_EXPERTS = PEER_NKEYS * PEER_NKEYS
PEER_QDIM = 256
PEER_HALF = PEER_QDIM // 2
PEER_TOPK = 16
PEER_BLOCK = 128
ALPHA = (2 * DEPTH) ** 0.25
BETA = (8 * DEPTH) ** -0.25
LN_EPS = 1e-5
PROJ_SIZES = (W_LRU, W_LRU, 2 * W_CONF, N_HEADS * HEAD_DIM, N_KV * HEAD_DIM, N_KV * HEAD_DIM,
              N_IDX_HEADS * IDX_DIM, IDX_DIM, N_IDX_HEADS, W_POOL, N_BRANCH * D_MODEL)
PROJ_TOTAL = 15432

kernel_name = 'hybrid_stream_rglru_conformer_dsa_pool_peer_step'


def _layer_norm(x, g, b):
    xf = x.astype(jnp.float32)
    mu = jnp.mean(xf, -1, keepdims=True)
    var = jnp.mean(jnp.square(xf - mu), -1, keepdims=True)
    y = (xf - mu) * lax.rsqrt(var + LN_EPS) * g.astype(jnp.float32) + b.astype(jnp.float32)
    return y.astype(x.dtype)


def _rope_partial(x, pos, rot):
    half = rot // 2
    inv = ROPE_THETA ** (-jnp.arange(half, dtype=jnp.float32) / half)
    ang = pos.astype(jnp.float32)[:, None] * inv[None, :]
    cos = jnp.cos(ang)[None, :, None, :]
    sin = jnp.sin(ang)[None, :, None, :]
    xr = x[..., :rot].astype(jnp.float32)
    x1, x2 = xr[..., :half], xr[..., half:]
    rot_part = jnp.concatenate([x1 * cos - x2 * sin, x2 * cos + x1 * sin], -1)
    return jnp.concatenate([rot_part.astype(x.dtype), x[..., rot:]], -1)


def _causal_dwconv(buf, x, w, b):
    t = x.shape[1]
    xp = jnp.concatenate([buf.astype(x.dtype), x], axis=1)
    y = lax.conv_general_dilated(xp, w.astype(x.dtype)[:, None, :], (1,), 'VALID',
                                 dimension_numbers=('NWC', 'WIO', 'NWC'),
                                 feature_group_count=x.shape[-1])
    return y + b.astype(x.dtype), xp[:, t:]


def _lin_combine(left, right):
    a_l, b_l = left
    a_r, b_r = right
    return a_l * a_r, a_r * b_l + b_r


def _rglru(xc, h0, w_r, b_r, w_i, b_i, lam):
    bsz, t, c = xc.shape
    xb = xc.reshape(bsz, t, LRU_BLOCKS, c // LRU_BLOCKS)
    gr = jnp.einsum('btnc,ncd->btnd', xb, w_r).reshape(bsz, t, c) + b_r
    gi = jnp.einsum('btnc,ncd->btnd', xb, w_i).reshape(bsz, t, c) + b_i
    r = jax.nn.sigmoid(gr.astype(jnp.float32))
    i = jax.nn.sigmoid(gi.astype(jnp.float32))
    log_a = -LRU_C * r * jax.nn.softplus(-lam.astype(jnp.float32))
    a = jnp.exp(log_a)
    u = jnp.sqrt(-jnp.expm1(2.0 * log_a)) * i * xc.astype(jnp.float32)
    u = u.at[:, 0].add(a[:, 0] * h0.astype(jnp.float32))
    _, h = lax.associative_scan(_lin_combine, (a, u), axis=1)
    return h, h[:, -1]


def _pool_mix(buf, xin, w_pool, scale):
    bsz, t, c = xin.shape
    xp = jnp.concatenate([buf.astype(xin.dtype), xin], axis=1)
    xf = xp.astype(jnp.float32)
    cs = jnp.concatenate([jnp.zeros((bsz, 1, c), jnp.float32), jnp.cumsum(xf, axis=1)], axis=1)
    means = []
    for g, w in enumerate(POOL_WINDOWS):
        lo = g * POOL_GW
        hi = lo + POOL_GW
        win_sum = cs[:, POOL_BUF + 1:, lo:hi] - cs[:, POOL_BUF + 1 - w:POOL_BUF + 1 - w + t, lo:hi]
        means.append(win_sum * (1.0 / w))
    diff = jnp.concatenate(means, -1) - xf[:, POOL_BUF:]
    diff = diff.astype(xin.dtype).reshape(bsz, t, POOL_GROUPS, POOL_GW)
    y = jnp.einsum('btgc,gcd->btgd', diff, w_pool).reshape(bsz, t, c) * scale
    return y, xp[:, t:]


def _dsa_block(q, qi, wi, q_pos, k_all, v_all, ki_all, n_top):
    bsz, tq = q.shape[0], q.shape[1]
    n_keys = k_all.shape[1]
    limit = (q_pos // CHUNK + 1) * CHUNK
    adm = jnp.arange(n_keys, dtype=jnp.int32)[None, :] < limit[:, None]
    dots = jnp.einsum('bqhd,bsd->bqhs', qi, ki_all).astype(jnp.float32)
    score = jnp.einsum('bqh,bqhs->bqs', wi.astype(jnp.float32), jax.nn.relu(dots))
    score = jnp.where(adm[None], score, -jnp.inf)
    _, idx = lax.top_k(score, n_top)
    valid = idx < limit[None, :, None]
    gather = jax.vmap(lambda rows, ids: rows[ids])
    kg = gather(k_all, idx)
    vg = gather(v_all, idx)
    qg = q.reshape(bsz, tq, N_KV, N_HEADS // N_KV, HEAD_DIM)
    s = jnp.einsum('bqgrd,bqkgd->bqgrk', qg, kg).astype(jnp.float32) * (HEAD_DIM ** -0.5)
    s = jnp.where(valid[:, :, None, None, :], s, -jnp.inf)
    p = jax.nn.softmax(s, axis=-1).astype(vg.dtype)
    o = jnp.einsum('bqgrk,bqkgd->bqgrd', p, vg)
    return o.reshape(bsz, tq, N_HEADS * HEAD_DIM)


def _dsa_attention(q, qi, wi, pos, k_all, v_all, ki_all):
    bsz, t = q.shape[0], q.shape[1]
    n_top = min(TOPK_ATT, k_all.shape[1] // 4)
    if t > Q_BLOCK and t % Q_BLOCK == 0:
        nb = t // Q_BLOCK

        def to_blocks(a):
            return jnp.moveaxis(a.reshape((bsz, nb, Q_BLOCK) + a.shape[2:]), 1, 0)

        def one_block(args):
            qb, qib, wib, pb = args
            return _dsa_block(qb, qib, wib, pb, k_all, v_all, ki_all, n_top)

        out = lax.map(one_block, (to_blocks(q), to_blocks(qi), to_blocks(wi), pos.reshape(nb, Q_BLOCK)))
        return jnp.moveaxis(out, 0, 1).reshape(bsz, t, N_HEADS * HEAD_DIM)
    return _dsa_block(q, qi, wi, pos, k_all, v_all, ki_all, n_top)


def _peer(x, w_q, sub_keys, u_tab, v_tab):
    bsz, t, d = x.shape
    n = bsz * t
    nb = -(-n // PEER_BLOCK)
    xt = jnp.pad(x.reshape(n, d), ((0, nb * PEER_BLOCK - n), (0, 0))).reshape(nb, PEER_BLOCK, d)

    def one_block(xb):
        q = (xb @ w_q).reshape(PEER_BLOCK, PEER_HEADS, 2, PEER_HALF)
        s = jnp.einsum('thcd,hcnd->thcn', q, sub_keys).astype(jnp.float32)
        sv, si = lax.top_k(s, PEER_TOPK)
        cand = sv[:, :, 0, :, None] + sv[:, :, 1, None, :]
        fv, fi = lax.top_k(cand.reshape(PEER_BLOCK, PEER_HEADS, PEER_TOPK * PEER_TOPK), PEER_TOPK)
        i1 = jnp.take_along_axis(si[:, :, 0], fi // PEER_TOPK, axis=-1)
        i2 = jnp.take_along_axis(si[:, :, 1], fi % PEER_TOPK, axis=-1)
        eid = i1 * PEER_NKEYS + i2
        g = jax.nn.softmax(fv, axis=-1)
        ug = u_tab[eid]
        vg = v_tab[eid]
        act = jnp.einsum('td,thkd->thk', xb, ug).astype(jnp.float32)
        coef = (g * jax.nn.gelu(act)).astype(xb.dtype)
        return jnp.einsum('thk,thkd->td', coef, vg)

    y = lax.map(one_block, xt).reshape(nb * PEER_BLOCK, d)[:n]
    return y.reshape(bsz, t, d)


def _trunk(x, pos0, past_k, past_v, past_ki, h0, lru_buf, conf_buf, pool_buf, prm):
    bsz, t, _ = x.shape
    pos = pos0 + jnp.arange(t, dtype=jnp.int32)
    offs = [int(o) for o in np.cumsum(PROJ_SIZES)[:-1]]
    ks, vs, kis, hs, lbs, cbs, pbs = [], [], [], [], [], [], []
    for l in range(DEPTH):
        z = jnp.einsum('btd,de->bte', x, prm['w_in'][l])
        za, zg, zb, zq, zk, zv, zqi, zki, zwi, zp, zgate = jnp.split(z, offs, axis=-1)
        xc, lru_new = _causal_dwconv(lru_buf[l], za, prm['lru_conv_w'][l], prm['lru_conv_b'][l])
        h, h_last = _rglru(xc, h0[l], prm['lru_wr'][l], prm['lru_br'][l], prm['lru_wi'][l],
                           prm['lru_bi'][l], prm['lru_lambda'][l])
        y_a = h.astype(x.dtype) * jax.nn.gelu(zg)
        glu = zb[..., :W_CONF] * jax.nn.sigmoid(zb[..., W_CONF:])
        cb, conf_new = _causal_dwconv(conf_buf[l], glu, prm['conf_conv_w'][l], prm['conf_conv_b'][l])
        y_b = jax.nn.silu(_layer_norm(cb, prm['conf_ln_g'][l], prm['conf_ln_b'][l]))
        q = _rope_partial(zq.reshape(bsz, t, N_HEADS, HEAD_DIM), pos, ROT_DIM)
        k = _rope_partial(zk.reshape(bsz, t, N_KV, HEAD_DIM), pos, ROT_DIM)
        v = zv.reshape(bsz, t, N_KV, HEAD_DIM)
        qi = _rope_partial(zqi.reshape(bsz, t, N_IDX_HEADS, IDX_DIM), pos, IDX_ROT)
        ki = _rope_partial(zki[:, :, None, :], pos, IDX_ROT)[:, :, 0, :]
        k_all = jnp.concatenate([past_k[l].astype(x.dtype), k], axis=1)
        v_all = jnp.concatenate([past_v[l].astype(x.dtype), v], axis=1)
        ki_all = jnp.concatenate([past_ki[l].astype(x.dtype), ki], axis=1)
        y_c = _dsa_attention(q, qi, zwi, pos, k_all, v_all, ki_all)
        y_d, pool_new = _pool_mix(pool_buf[l], zp, prm['pool_w'][l], prm['pool_scale'][l])
        branches = jnp.stack([y_a, y_b, y_c, y_d], axis=2)
        proj = jnp.einsum('btnw,nwd->btnd', branches, prm['w_branch'][l])
        gates = jax.nn.sigmoid(zgate.reshape(bsz, t, N_BRANCH, D_MODEL))
        mix = jnp.sum(gates * proj, axis=2) @ prm['w_out'][l]
        x = _layer_norm(ALPHA * x + mix, prm['ln1_g'][l], prm['ln1_b'][l])
        ffn = _peer(x, prm['peer_wq'][l], prm['peer_subkeys'][l], prm['peer_u'][l], prm['peer_v'][l])
        x = _layer_norm(ALPHA * x + ffn, prm['ln2_g'][l], prm['ln2_b'][l])
        ks.append(k)
        vs.append(v)
        kis.append(ki)
        hs.append(h_last)
        lbs.append(lru_new)
        cbs.append(conf_new)
        pbs.append(pool_new)
    states = (jnp.stack(ks), jnp.stack(vs), jnp.stack(kis), jnp.stack(hs),
              jnp.stack(lbs), jnp.stack(cbs), jnp.stack(pbs))
    return x, states


def setup_inputs(seed: int = 0) -> dict:
    key = jax.random.key(seed)
    ks = jax.random.split(key, 33)

    def nrm(i, shape, scale):
        return jax.random.normal(ks[i], shape, jnp.float32) * scale

    a0 = jax.random.uniform(ks[17], (DEPTH, W_LRU), jnp.float32, 0.9, 0.999)
    return {
        'x_prompt': nrm(0, (BATCH, SEQ, D_MODEL), 1.0),
        'x_sample': nrm(1, (DEC_BATCH, DEC_SEQ, D_MODEL), 1.0),
        'cache_k': nrm(2, (DEPTH, DEC_BATCH, PAST_LEN, N_KV, HEAD_DIM), 1.0),
        'cache_v': nrm(3, (DEPTH, DEC_BATCH, PAST_LEN, N_KV, HEAD_DIM), 1.0),
        'cache_kidx': nrm(4, (DEPTH, DEC_BATCH, PAST_LEN, IDX_DIM), 1.0),
        'state_lru_h': nrm(5, (DEPTH, DEC_BATCH, W_LRU), 0.5),
        'state_lru_conv': nrm(6, (DEPTH, DEC_BATCH, LRU_CONV - 1, W_LRU), 1.0),
        'state_conf_conv': nrm(7, (DEPTH, DEC_BATCH, CONF_CONV - 1, W_CONF), 1.0),
        'state_pool': nrm(8, (DEPTH, DEC_BATCH, POOL_BUF, W_POOL), 1.0),
        'w_in': nrm(9, (DEPTH, D_MODEL, PROJ_TOTAL), D_MODEL ** -0.5),
        'lru_conv_w': nrm(10, (DEPTH, LRU_CONV, W_LRU), LRU_CONV ** -0.5),
        'lru_conv_b': nrm(11, (DEPTH, W_LRU), 0.01),
        'lru_wr': nrm(12, (DEPTH, LRU_BLOCKS, W_LRU // LRU_BLOCKS, W_LRU // LRU_BLOCKS), (W_LRU // LRU_BLOCKS) ** -0.5),
        'lru_br': nrm(13, (DEPTH, W_LRU), 0.01),
        'lru_wi': nrm(14, (DEPTH, LRU_BLOCKS, W_LRU // LRU_BLOCKS, W_LRU // LRU_BLOCKS), (W_LRU // LRU_BLOCKS) ** -0.5),
        'lru_bi': nrm(15, (DEPTH, W_LRU), 0.01),
        'lru_lambda': jnp.log(a0) - jnp.log1p(-a0) + nrm(16, (DEPTH, W_LRU), 0.01),
        'conf_conv_w': nrm(18, (DEPTH, CONF_CONV, W_CONF), CONF_CONV ** -0.5),
        'conf_conv_b': nrm(19, (DEPTH, W_CONF), 0.01),
        'conf_ln_g': 1.0 + nrm(20, (DEPTH, W_CONF), 0.05),
        'conf_ln_b': nrm(21, (DEPTH, W_CONF), 0.01),
        'pool_w': nrm(22, (DEPTH, POOL_GROUPS, POOL_GW, POOL_GW), POOL_GW ** -0.5),
        'pool_scale': 1.0 + nrm(23, (DEPTH, W_POOL), 0.1),
        'w_branch': nrm(24, (DEPTH, N_BRANCH, W_BRANCH, D_MODEL), W_BRANCH ** -0.5),
        'w_out': nrm(25, (DEPTH, D_MODEL, D_MODEL), BETA * D_MODEL ** -0.5),
        'ln1_g': 1.0 + nrm(26, (DEPTH, D_MODEL), 0.05),
        'ln1_b': nrm(27, (DEPTH, D_MODEL), 0.01),
        'peer_wq': nrm(28, (DEPTH, D_MODEL, PEER_HEADS * PEER_QDIM), D_MODEL ** -0.5),
        'peer_subkeys': nrm(29, (DEPTH, PEER_HEADS, 2, PEER_NKEYS, PEER_HALF), PEER_HALF ** -0.5),
        'peer_u': nrm(30, (DEPTH, PEER_EXPERTS, D_MODEL), D_MODEL ** -0.5),
        'peer_v': nrm(31, (DEPTH, PEER_EXPERTS, D_MODEL), BETA * PEER_HEADS ** -0.5),
        'ln2_g': 1.0 + nrm(32, (DEPTH, D_MODEL), 0.05),
        'ln2_b': nrm(26, (DEPTH, D_MODEL), 0.01) * 0.5 + nrm(27, (DEPTH, D_MODEL), 0.01),
    }


def reference(x_prompt, x_sample, cache_k, cache_v, cache_kidx, state_lru_h, state_lru_conv,
              state_conf_conv, state_pool, w_in, lru_conv_w, lru_conv_b, lru_wr, lru_br, lru_wi,
              lru_bi, lru_lambda, conf_conv_w, conf_conv_b, conf_ln_g, conf_ln_b, pool_w, pool_scale,
              w_branch, w_out, ln1_g, ln1_b, peer_wq, peer_subkeys, peer_u, peer_v, ln2_g, ln2_b):
    prm = {
        'w_in': w_in, 'lru_conv_w': lru_conv_w, 'lru_conv_b': lru_conv_b, 'lru_wr': lru_wr,
        'lru_br': lru_br, 'lru_wi': lru_wi, 'lru_bi': lru_bi, 'lru_lambda': lru_lambda,
        'conf_conv_w': conf_conv_w, 'conf_conv_b': conf_conv_b, 'conf_ln_g': conf_ln_g,
        'conf_ln_b': conf_ln_b, 'pool_w': pool_w, 'pool_scale': pool_scale, 'w_branch': w_branch,
        'w_out': w_out, 'ln1_g': ln1_g, 'ln1_b': ln1_b, 'peer_wq': peer_wq,
        'peer_subkeys': peer_subkeys, 'peer_u': peer_u, 'peer_v': peer_v, 'ln2_g': ln2_g, 'ln2_b': ln2_b,
    }
    bp = x_prompt.shape[0]
    dt = x_prompt.dtype
    y_prompt, st_p = _trunk(
        x_prompt, 0,
        jnp.zeros((DEPTH, bp, 0, N_KV, HEAD_DIM), dt),
        jnp.zeros((DEPTH, bp, 0, N_KV, HEAD_DIM), dt),
        jnp.zeros((DEPTH, bp, 0, IDX_DIM), dt),
        jnp.zeros((DEPTH, bp, W_LRU), jnp.float32),
        jnp.zeros((DEPTH, bp, LRU_CONV - 1, W_LRU), dt),
        jnp.zeros((DEPTH, bp, CONF_CONV - 1, W_CONF), dt),
        jnp.zeros((DEPTH, bp, POOL_BUF, W_POOL), dt),
        prm)
    k_p, v_p, kidx_p, h_p, lconv_p, cconv_p, pool_p = st_p
    y_sample, st_s = _trunk(
        x_sample, cache_k.shape[2], cache_k, cache_v, cache_kidx, state_lru_h,
        state_lru_conv, state_conf_conv, state_pool, prm)
    k_s, v_s, kidx_s, h_s, lconv_s, cconv_s, pool_s = st_s
    return (y_prompt, y_sample, k_p, v_p, kidx_p, h_p, lconv_p, cconv_p, pool_p,
            k_s, v_s, kidx_s, h_s, lconv_s, cconv_s, pool_s)
```

```cpp
#include <hip/hip_runtime.h>
#include <cstdio>
#include <cstdint>

#define LAS __attribute__((address_space(3)))
typedef unsigned short bf16_t;
typedef short bf16x8 __attribute__((ext_vector_type(8)));
typedef float f32x4 __attribute__((ext_vector_type(4)));
typedef float f32x2 __attribute__((ext_vector_type(2)));
typedef float f32x16 __attribute__((ext_vector_type(16)));
typedef unsigned u32x4 __attribute__((ext_vector_type(4)));
typedef unsigned u32x2 __attribute__((ext_vector_type(2)));
typedef unsigned long long u64;

constexpr int D = 2048, SEQ = 4096, MP = 2 * SEQ, DB = 32, DSQ = 64, MS = DB * DSQ, M = MP + MS, PAST = 2048, SKS = PAST + DSQ;
constexpr int NT_BF = 29;
constexpr int NPROJ = 15432, NPAD = 15616, NT_IN = NPAD / 256;
constexpr int WL = 1024;
constexpr int NEXP = 16384;
constexpr float ALPHA = 1.41421356237f;
constexpr float LN_EPS = 1e-5f;
constexpr float QSCALE = 0.08838834764831845f * 1.4426950408889634f;

constexpr size_t O_YP = 0, O_YS = O_YP + (size_t)MP * D, O_KP = O_YS + (size_t)MS * D, O_VP = O_KP + (size_t)2 * MP * 256, O_KIP = O_VP + (size_t)2 * MP * 256,
    O_HP = O_KIP + (size_t)2 * MP * 64, O_LCP = O_HP + 2 * 2 * 1024, O_CCP = O_LCP + 2 * 2 * 3 * 1024, O_PP = O_CCP + 2 * 2 * 30 * 1024, O_KS = O_PP + 2 * 2 * 15 * 1024,
    O_VS = O_KS + (size_t)2 * MS * 256, O_KIS = O_VS + (size_t)2 * MS * 256, O_HS = O_KIS + (size_t)2 * MS * 64, O_LCS = O_HS + 2 * 32 * 1024, O_CCS = O_LCS + 2 * 32 * 3 * 1024,
    O_PS = O_CCS + 2 * 32 * 30 * 1024, O_END = O_PS + 2 * 32 * 15 * 1024;
static_assert(O_END == 36179968, "output size");

constexpr size_t al256(size_t x) { return (x + 255) & ~(size_t)255; }
constexpr size_t WS_CTL = 0, CTL_BYTES = 1u << 20;
constexpr size_t WS_WIN = CTL_BYTES;
constexpr size_t WS_WBR = WS_WIN + (size_t)2 * NPAD * 2048 * 2;
constexpr size_t WS_WOUT = WS_WBR + (size_t)2 * 8192 * 1024 * 2;
constexpr size_t WS_WQ = WS_WOUT + (size_t)2 * 2048 * 2048 * 2;
constexpr size_t WS_POOLT = WS_WQ + (size_t)2 * 2048 * 2048 * 2;
constexpr size_t WS_LRUW = WS_POOLT + (size_t)2 * 1024 * 256 * 2;
constexpr size_t WS_SK = WS_LRUW + (size_t)2 * 2 * 16 * 64 * 64 * 2;
constexpr size_t WS_ROPE = WS_SK + (size_t)2 * 8 * 2 * 128 * 128 * 2;
constexpr size_t WS_U = WS_ROPE + (size_t)4096 * 48 * 4;
constexpr size_t WS_V = WS_U + (size_t)2 * NEXP * 2048 * 2;
constexpr size_t WS_XB = WS_V + (size_t)2 * NEXP * 2048 * 2;
constexpr size_t WS_XF = WS_XB + (size_t)M * D * 2;
constexpr size_t WS_ZA = WS_XF + (size_t)M * D * 4;
constexpr size_t WS_GZ = WS_ZA + (size_t)M * WL * 2;
constexpr size_t WS_GLU = WS_GZ + (size_t)M * WL * 2;
constexpr size_t WS_Q = WS_GLU + (size_t)M * WL * 2;
constexpr size_t WS_ZP = WS_Q + (size_t)M * WL * 2;
constexpr size_t WS_DIFF = WS_ZP + (size_t)M * WL * 2;
constexpr size_t WS_KP = WS_DIFF + (size_t)M * WL * 2;
constexpr size_t WS_VP = WS_KP + (size_t)MP * 256 * 2;
constexpr size_t WS_KS = WS_VP + (size_t)MP * 256 * 2;
constexpr size_t WS_VS = WS_KS + (size_t)DB * SKS * 256 * 2;
constexpr size_t WS_QI = WS_VS + (size_t)DB * SKS * 256 * 2;
constexpr size_t WS_KIP = WS_QI + (size_t)M * 512 * 2;
constexpr size_t WS_KIS = WS_KIP + (size_t)MP * 64 * 2;
constexpr size_t WS_WI = WS_KIS + (size_t)DB * SKS * 64 * 2;
constexpr size_t WS_GATES = WS_WI + (size_t)M * 8 * 4;
constexpr size_t WS_Y = WS_GATES + (size_t)M * 8192 * 2;
constexpr size_t WS_R1 = WS_Y + (size_t)4 * M * WL * 2;
constexpr size_t WS_SEL = WS_R1 + (size_t)M * 4096 * 4;
constexpr size_t WS_EID = WS_SEL + (size_t)M * 64 * 8;
constexpr size_t WS_GW = WS_EID + (size_t)M * 128 * 4;
constexpr size_t WS_CH = WS_GW + (size_t)M * 128 * 4;
constexpr size_t WS_USC = WS_CH + (size_t)2 * 64 * 1024 * 2 * 4;
constexpr size_t WS_VSC = WS_USC + (size_t)2 * NEXP * 4;
constexpr size_t WS_END = WS_VSC + (size_t)2 * NEXP * 4;
static_assert(WS_END < (size_t)1262 * 1024 * 1024, "workspace over budget");
constexpr size_t WS_WIN8 = WS_U + ((size_t)48 << 20);
constexpr size_t WS_XB8 = WS_U + ((size_t)96 << 20);
static_assert(WS_U + (size_t)2 * NEXP * 1024 + (size_t)2 * NEXP * 64 <= WS_WIN8 && WS_WIN8 + (size_t)2 * 8192 * 2048 <= WS_XB8 && WS_XB8 + (size_t)M * D <= WS_V, "fp8 operands overlap");
constexpr size_t WS_G = WS_Y, WS_SC = WS_R1, WS_PG = WS_R1, WS_PRE1 = WS_R1, WS_QP = WS_R1 + (size_t)M * D * 4;

constexpr int CW_BAR = 4096;
constexpr int LDS_BYTES = 147456;
constexpr int LDS_MISC = 131072 + 8192;
constexpr int NTHREADS = 512, NWAVES = 8;

__device__ __forceinline__ float bf2f(unsigned v) { return __uint_as_float(v << 16); }
__device__ __forceinline__ unsigned f2bf(float f) { unsigned u = __float_as_uint(f); return (u + 0x7fffu + ((u >> 16) & 1u)) >> 16; }
typedef __bf16 bf16x2n_t __attribute__((ext_vector_type(2)));
__device__ __forceinline__ unsigned pk2(float lo, float hi) { typedef float f2_ __attribute__((ext_vector_type(2))); const bf16x2n_t b = __builtin_convertvector((f2_){lo, hi}, bf16x2n_t); return __builtin_bit_cast(unsigned, b); }
__device__ __forceinline__ unsigned pk4_fp8(f32x4 v) { int w = 0; w = __builtin_amdgcn_cvt_pk_fp8_f32(v[0], v[1], w, false); w = __builtin_amdgcn_cvt_pk_fp8_f32(v[2], v[3], w, true); return (unsigned)w; }
__device__ __forceinline__ float bflo(unsigned w) { return __uint_as_float(w << 16); }
__device__ __forceinline__ float bfhi(unsigned w) { return __uint_as_float(w & 0xffff0000u); }
__device__ __forceinline__ float frcp(float x) { return __builtin_amdgcn_rcpf(x); }
__device__ __forceinline__ float sigmoidf_(float x) { return frcp(1.0f + __expf(-x)); }
__device__ __forceinline__ float sig255(float x) { return frcp(__builtin_fmaf(__expf(-x), 1.0f / 255.0f, 1.0f / 255.0f)); }
__device__ __forceinline__ unsigned pk4_u8(float a, float b, float c, float d) { unsigned w = 0u; w = __builtin_amdgcn_cvt_pk_u8_f32(a, 0, w); w = __builtin_amdgcn_cvt_pk_u8_f32(b, 1, w); w = __builtin_amdgcn_cvt_pk_u8_f32(c, 2, w); w = __builtin_amdgcn_cvt_pk_u8_f32(d, 3, w); return w; }
__device__ __forceinline__ float gate_u8(unsigned w, int k) { return __builtin_fmaf((float)((w >> (8 * k)) & 0xffu), 1.0f / 255.0f, 0.5f / 255.0f); }
__device__ __forceinline__ float gelu_tanh(float x) { const float u = 0.7978845608028654f * (x + 0.044715f * x * x * x); const float e = __expf(2.0f * u); return 0.5f * x * (2.0f - 2.0f * frcp(e + 1.0f)); }
__device__ __forceinline__ float sigmoid_ieee(float x) { return 1.0f / (1.0f + __expf(-x)); }
__device__ __forceinline__ float gelu_ieee(float x) { const float u = 0.7978845608028654f * (x + 0.044715f * x * x * x); const float e = __expf(2.0f * u); return 0.5f * x * (2.0f - 2.0f / (e + 1.0f)); }

__device__ __forceinline__ float wave_sum_dpp(float v) {
#define DPP_ADD(ctrl, rmask) v += __int_as_float(__builtin_amdgcn_update_dpp(0, __float_as_int(v), ctrl, rmask, 0xF, false))
    DPP_ADD(0xB1, 0xF);
    DPP_ADD(0x4E, 0xF);
    DPP_ADD(0x141, 0xF);
    DPP_ADD(0x140, 0xF);
    DPP_ADD(0x142, 0xA);
    DPP_ADD(0x143, 0xC);
#undef DPP_ADD
    return __int_as_float(__builtin_amdgcn_readlane(__float_as_int(v), 63));
}

__device__ __forceinline__ int fresh_lane() { int ln; asm volatile("v_mbcnt_lo_u32_b32 %0, -1, 0\n\tv_mbcnt_hi_u32_b32 %0, -1, %0" : "=v"(ln)); return ln; }
__device__ __forceinline__ float shflx(float v, int m) { const int ln = fresh_lane(); return __int_as_float(__builtin_amdgcn_ds_bpermute((ln ^ m) << 2, __float_as_int(v))); }
__device__ __forceinline__ int shflx_i(int v, int m) { const int ln = fresh_lane(); return __builtin_amdgcn_ds_bpermute((ln ^ m) << 2, v); }
__device__ __forceinline__ float wave_sum(float v) {
    const int ln = fresh_lane();
#pragma unroll
    for (int o = 1; o < 64; o <<= 1) v += __int_as_float(__builtin_amdgcn_ds_bpermute((ln ^ o) << 2, __float_as_int(v)));
    return v;
}

__device__ __forceinline__ float wave_max_dpp(float v) {
    const int ninf = (int)0xff800000u;
#define DPP_MAX(ctrl, rmask) v = fmaxf(v, __int_as_float(__builtin_amdgcn_update_dpp(ninf, __float_as_int(v), ctrl, rmask, 0xF, false)))
    DPP_MAX(0xB1, 0xF); DPP_MAX(0x4E, 0xF); DPP_MAX(0x141, 0xF); DPP_MAX(0x140, 0xF); DPP_MAX(0x142, 0xA); DPP_MAX(0x143, 0xC);
#undef DPP_MAX
    return __int_as_float(__builtin_amdgcn_readlane(__float_as_int(v), 63));
}
namespace pg8 {
#define PG8_LAS __attribute__((address_space(3)))
constexpr int BM = 256, BK = 64, HALF = 128, HTB = HALF * BK * 2  , STAGE_BYTES = 8 * HTB, NXCD = 8, WGM = 8;
__host__ __device__ __forceinline__ int lds_byte(int r, int c) { const int st = (r >> 4) * 2 + (c >> 5), rr = r & 15, cc = c & 31, ob = rr * 64 + cc * 2; return st * 1024 + (ob ^ (((ob >> 9) & 1) << 5)); }
__host__ __device__ __forceinline__ void stage_rc(int b, int& R, int& C) { const int st = b / 1024, sb = b % 1024, swz = sb ^ (((sb >> 9) & 1) << 5); R = (st >> 1) * 16 + swz / 64; C = (st & 1) * 32 + (swz % 64) / 2; }
__host__ __device__ __forceinline__ int perm32(int rho) { const int n = rho >> 4, i = rho & 15; return 8 * (i >> 2) + 4 * n + (i & 3); }

struct Unit { int pm, pn, z; size_t aoff, boff; };
struct Gemm { const bf16_t* A; const bf16_t* Bt; int lda, ldb, K; };

struct StaticOrder {
    int nM, nN, nwg, G, c, pn0; size_t astep, bstep;
    __device__ void init(int nM_, int nN_, int G_, int c_, int lda, int ldb) { nM = nM_; nN = nN_; nwg = nM * nN; G = G_; c = c_; pn0 = 0; astep = (size_t)256 * lda * 2; bstep = (size_t)256 * ldb * 2; }
    __device__ bool next(int i, Unit& u) const {
        const long L = (long)i * G + c; if (L >= nwg) return false;
        int wgid = (int)L; { const int q = nwg / NXCD, r = nwg % NXCD, xcd = wgid % NXCD, off = wgid / NXCD; wgid = (xcd < r ? xcd * (q + 1) : r * (q + 1) + (xcd - r) * q) + off; }
        const int nig = WGM * nN, gid = wgid / nig, fm = gid * WGM, gsz = (nM - fm) < WGM ? (nM - fm) : WGM;
        u.pm = fm + ((wgid % nig) % gsz); u.pn = (wgid % nig) / gsz; u.z = 0; u.aoff = (size_t)u.pm * astep; u.boff = (size_t)u.pn * bstep; u.pn += pn0; return true;
    }
};

__device__ __forceinline__ unsigned cvt_pk_bf16(float lo, float hi) { unsigned r; asm volatile("v_cvt_pk_bf16_f32 %0, %1, %2" : "=v"(r) : "v"(lo), "v"(hi)); return r; }

typedef int i32x8 __attribute__((ext_vector_type(8)));
__device__ __forceinline__ i32x8 cat8(bf16x8 lo, bf16x8 hi) { typedef int i32x4_ __attribute__((ext_vector_type(4))); const i32x4_ a = __builtin_bit_cast(i32x4_, lo), b = __builtin_bit_cast(i32x4_, hi); return __builtin_shufflevector(a, b, 0, 1, 2, 3, 4, 5, 6, 7); }
template <class Epi, class Sched, bool ALIGN_EPI, bool F8 = false>
__device__ __forceinline__ void gemm_phase(PG8_LAS unsigned char* lds, const Gemm g, const Sched& S, const Epi& E, const int wid) {
    const int lane = fresh_lane(), tid = wid * 64 + lane;
    const int wr = wid >> 2, wc = wid & 3, fr = lane & 15, fq = lane >> 4;
    int K = g.K; asm volatile("" : "+s"(K));
    const int nt = K / BK;
    unsigned voffA, voffB;
    { int R, C; stage_rc(tid * 16, R, C); const int Rb = Epi::PERM ? ((R & ~31) + perm32(R & 31)) : R; voffA = (unsigned)(R * g.lda + C) * 2u; voffB = (unsigned)(Rb * g.ldb + C) * 2u; }
    const unsigned voffA_d = 64u * (unsigned)g.lda * 2u, voffB_d = 64u * (unsigned)g.ldb * 2u;
    const size_t kstep = (size_t)(BK * 2);
    const size_t hA = (size_t)HALF * g.lda * 2, hB = (size_t)HALF * g.ldb * 2;
    const unsigned ldsw = (unsigned)wid * 1024u;
    const int aoff = lds_byte(wr * 64 + fr, fq * 8), boff = lds_byte(wc * 32 + fr, fq * 8);
#define PG8_SA(b, h) (((b) * 2 + (h)) * HTB)
#define PG8_SB(b, h) ((4 + (b) * 2 + (h)) * HTB)
#define PG8_STAGE(bufoff, gbase, voff) do { _Pragma("unroll") for (int _i = 0; _i < 2; ++_i) \
        { unsigned vo_ = (voff) + _i * voff##_d; asm volatile("" : "+v"(vo_)); __builtin_amdgcn_global_load_lds((const unsigned*)((const char*)(gbase) + vo_), (PG8_LAS unsigned*)(lds + (bufoff) + ldsw + _i * 8192), 16, 0, 0); } } while (0)
#define PG8_LDA(dst, b, h) do { _Pragma("unroll") for (int m = 0; m < 4; ++m) _Pragma("unroll") for (int k = 0; k < 2; ++k) dst[m][k] = *(const PG8_LAS bf16x8*)(lds + PG8_SA(b, h) + aoff + m * 2048 + k * 1024); } while (0)
#define PG8_LDB(dst, b, h) do { _Pragma("unroll") for (int n = 0; n < 2; ++n) _Pragma("unroll") for (int k = 0; k < 2; ++k) dst[n][k] = *(const PG8_LAS bf16x8*)(lds + PG8_SB(b, h) + boff + n * 2048 + k * 1024); } while (0)
#define PG8_MMA(ai, bj, At, Bt) do { __builtin_amdgcn_s_setprio(1); \
        if constexpr (F8) { _Pragma("unroll") for (int m = 0; m < 4; ++m) _Pragma("unroll") for (int n = 0; n < 2; ++n) \
            acc[ai][bj][m][n] = __builtin_amdgcn_mfma_scale_f32_16x16x128_f8f6f4(cat8(Bt[n][0], Bt[n][1]), cat8(At[m][0], At[m][1]), acc[ai][bj][m][n], 0, 0, 0, 0, 0, 0); } \
        else { _Pragma("unroll") for (int m = 0; m < 4; ++m) _Pragma("unroll") for (int n = 0; n < 2; ++n) _Pragma("unroll") for (int k = 0; k < 2; ++k) \
            acc[ai][bj][m][n] = __builtin_amdgcn_mfma_f32_16x16x32_bf16(Bt[n][k], At[m][k], acc[ai][bj][m][n], 0, 0, 0); } \
        __builtin_amdgcn_s_setprio(0); } while (0)
#define PG8_WAIT_V(n) asm volatile("s_waitcnt vmcnt(" #n ")" ::: "memory")
#define PG8_WAIT_L(n) asm volatile("s_waitcnt lgkmcnt(" #n ")" ::: "memory")
#define PG8_BAR __builtin_amdgcn_s_barrier()
#define PG8_SCHED __builtin_amdgcn_sched_barrier(0)
    Unit cur, nxt; int ui = 0;
    if (!S.next(0, cur)) return;
    f32x4 acc[2][2][4][2];
#pragma unroll
    for (int a = 0; a < 2; ++a)
#pragma unroll
        for (int b = 0; b < 2; ++b)
#pragma unroll
            for (int m = 0; m < 4; ++m)
#pragma unroll
                for (int n = 0; n < 2; ++n) acc[a][b][m][n] = (f32x4){0.f, 0.f, 0.f, 0.f};
    bf16x8 At[4][2], B0[2][2], B1[2][2];
    const char* cA = (const char*)g.A + cur.aoff; const char* cB = (const char*)g.Bt + cur.boff;
    PG8_STAGE(PG8_SB(0, 0), cB, voffB); PG8_STAGE(PG8_SB(0, 1), cB + hB, voffB); PG8_STAGE(PG8_SA(0, 0), cA, voffA); PG8_STAGE(PG8_SA(0, 1), cA + hA, voffA);
    if (wr == 1) PG8_BAR;
    PG8_WAIT_V(2); PG8_BAR;
    PG8_STAGE(PG8_SB(1, 0), cB + kstep, voffB); PG8_STAGE(PG8_SA(1, 0), cA + kstep, voffA); PG8_STAGE(PG8_SB(1, 1), cB + hB + kstep, voffB);
    PG8_WAIT_V(6); PG8_BAR;
    for (;;) {
        const bool has_next = S.next(ui + 1, nxt);
        const char* nA = has_next ? (const char*)g.A + nxt.aoff : cA; const char* nB = has_next ? (const char*)g.Bt + nxt.boff : cB;
        for (int t = 0; t < nt; t += 2) {
            const bool last = (t == nt - 2);
            const char* a1 = cA + (size_t)(t + 1) * kstep;
            const char* a2 = last ? nA : cA + (size_t)(t + 2) * kstep; const char* b2 = last ? nB : cB + (size_t)(t + 2) * kstep;
            const char* a3 = a2 + kstep; const char* b3 = b2 + kstep;
            PG8_LDB(B0, 0, 0); PG8_LDB(B1, 0, 1); PG8_SCHED; PG8_LDA(At, 0, 0); PG8_STAGE(PG8_SA(1, 1), a1 + hA, voffA);
            PG8_WAIT_V(8); PG8_WAIT_L(0); PG8_BAR; PG8_MMA(0, 0, At, B0); PG8_MMA(0, 1, At, B1); PG8_BAR; PG8_SCHED;
            PG8_LDA(At, 0, 1); PG8_STAGE(PG8_SB(0, 0), b2, voffB); PG8_STAGE(PG8_SB(0, 1), b2 + hB, voffB); PG8_STAGE(PG8_SA(0, 0), a2, voffA);
            PG8_WAIT_V(8); PG8_WAIT_L(0); PG8_BAR; PG8_MMA(1, 0, At, B0); PG8_MMA(1, 1, At, B1); PG8_BAR; PG8_SCHED;
            PG8_LDB(B0, 1, 0); PG8_LDB(B1, 1, 1); PG8_SCHED; PG8_LDA(At, 1, 0); PG8_STAGE(PG8_SA(0, 1), a2 + hA, voffA);
            PG8_WAIT_V(8); PG8_WAIT_L(0); PG8_BAR; PG8_MMA(0, 0, At, B0); PG8_MMA(0, 1, At, B1); PG8_BAR; PG8_SCHED;
            PG8_LDA(At, 1, 1); PG8_STAGE(PG8_SB(1, 0), b3, voffB); PG8_STAGE(PG8_SB(1, 1), b3 + hB, voffB); PG8_STAGE(PG8_SA(1, 0), a3, voffA);
            PG8_WAIT_V(8); PG8_WAIT_L(0); PG8_BAR; PG8_MMA(1, 0, At, B0); PG8_MMA(1, 1, At, B1); PG8_BAR; PG8_SCHED;
        }
        if constexpr (ALIGN_EPI) { if (wr == 0) PG8_BAR; }
        { const int ln_ = fresh_lane(); E(acc, cur, wr, wc, ln_ & 15, ln_ >> 4); }
        if (!has_next) break;
#pragma unroll
        for (int a = 0; a < 2; ++a)
#pragma unroll
            for (int b = 0; b < 2; ++b)
#pragma unroll
                for (int m = 0; m < 4; ++m)
#pragma unroll
                    for (int n = 0; n < 2; ++n) acc[a][b][m][n] = (f32x4){0.f, 0.f, 0.f, 0.f};
        cur = nxt; cA = nA; cB = nB; ++ui;
        if constexpr (ALIGN_EPI) { if (wr == 1) PG8_BAR; }
    }
    PG8_WAIT_V(0);
    if constexpr (!ALIGN_EPI) { if (wr == 0) PG8_BAR; }
    PG8_BAR;
#undef PG8_SA
#undef PG8_SB
#undef PG8_STAGE
#undef PG8_LDA
#undef PG8_LDB
#undef PG8_MMA
#undef PG8_WAIT_V
#undef PG8_WAIT_L
#undef PG8_BAR
#undef PG8_SCHED
}
}
#define XB_TMO      128
#define XB_XCNT(j)  (256  + 64 * (j))
#define XB_XSUB(j)  (1280 + 64 * (j))
#define XB_XGEN(j)  (2304 + 64 * (j))
#define XB_TOP      3328
#define XB_TOPGEN   3392
#define XCD_BAR_WORDS 3456
#define XB_SPIN_CAP (1u << 18)
__device__ __forceinline__ unsigned xb_ld(unsigned* p)              { return __hip_atomic_load(p, __ATOMIC_RELAXED, __HIP_MEMORY_SCOPE_AGENT); }
__device__ __forceinline__ unsigned xb_add(unsigned* p, unsigned v) { return __hip_atomic_fetch_add(p, v, __ATOMIC_RELAXED, __HIP_MEMORY_SCOPE_AGENT); }
__device__ __forceinline__ unsigned xb_xcc_id() { return (unsigned)__builtin_amdgcn_s_getreg((3 << 11) | 20) & 0xFu; }
#define XB_SPIN(cond, bar) do { unsigned _sp = 0; while (cond) { __builtin_amdgcn_s_sleep(1); \
    if ((++_sp & 255u) == 0u) { if (xb_ld(&(bar)[XB_TMO])) break; if (_sp > XB_SPIN_CAP) { atomicAdd(&(bar)[XB_TMO], 1u); break; } } } } while (0)
struct XcdBarrier { unsigned* bar; unsigned x; volatile LAS unsigned* st; };
__device__ __forceinline__ XcdBarrier xcd_barrier_post(unsigned* bar, volatile LAS unsigned* st) {
    XcdBarrier b; b.bar = bar; b.x = xb_xcc_id(); b.st = st;
    if (threadIdx.x == 0) (void)xb_add(&bar[XB_XCNT(b.x)], 1u);
    return b;
}
__device__ __forceinline__ void xcd_barrier_complete(unsigned* bar, unsigned x, unsigned& nloc, unsigned& nx) {
    const unsigned G = gridDim.x * gridDim.y * gridDim.z;
    unsigned sum, cnt, mine, sp = 0u;
    for (;;) {
        sum = 0u; cnt = 0u; mine = 0u;
#pragma unroll
        for (unsigned j = 0; j < 16; ++j) { const unsigned c = xb_ld(&bar[XB_XCNT(j)]); sum += c; cnt += (c > 0u) ? 1u : 0u; mine = (j == x) ? c : mine; }
        if (sum == G) break;
        __builtin_amdgcn_s_sleep(1);
        if ((++sp & 255u) == 0u) { if (xb_ld(&bar[XB_TMO])) break; if (sp > XB_SPIN_CAP) { atomicAdd(&bar[XB_TMO], 1u); break; } }
    }
    nloc = mine > 0u ? mine : 1u; nx = cnt > 0u ? cnt : 1u;
}
__device__ __forceinline__ void xcd_barrier(const XcdBarrier& b) {
    asm volatile("s_waitcnt vmcnt(0)" ::: "memory");
    __syncthreads();
    if (threadIdx.x == 0) {
        unsigned* bar = b.bar; unsigned bx = b.x; asm volatile("" : "+s"(bar), "+s"(bx));
        __builtin_amdgcn_s_waitcnt(0);
        const unsigned nloc = b.st[0], nx = b.st[1];
        const unsigned old = xb_add(&bar[XB_XSUB(bx)], 1u);
        const unsigned gen = old / nloc;
        if (old + 1u == (gen + 1u) * nloc) {
            __builtin_amdgcn_fence(__ATOMIC_RELEASE, "agent");
            asm volatile("s_waitcnt vmcnt(0)" ::: "memory");
            const unsigned og = xb_add(&bar[XB_TOP], 1u);
            const unsigned tg = og / nx;
            if (og + 1u == (tg + 1u) * nx) xb_add(&bar[XB_TOPGEN], 1u);
            else XB_SPIN(xb_ld(&bar[XB_TOPGEN]) == tg, bar);
            __builtin_amdgcn_fence(__ATOMIC_ACQUIRE, "agent");
            xb_add(&bar[XB_XGEN(bx)], 1u);
            asm volatile("s_waitcnt vmcnt(0)" ::: "memory");
        } else {
            XB_SPIN(xb_ld(&bar[XB_XGEN(bx)]) == gen, bar);
            __builtin_amdgcn_fence(__ATOMIC_ACQUIRE, "agent");
            asm volatile("s_waitcnt vmcnt(0)" ::: "memory");
        }
    }
    __syncthreads();
}

__device__ __forceinline__ void xcd_barrier_census(const XcdBarrier& b) {
    if (threadIdx.x == 0) { unsigned nloc, nx; xcd_barrier_complete(b.bar, b.x, nloc, nx); b.st[0] = nloc; b.st[1] = nx; }
    __syncthreads();
}

struct Args { const float* in[33]; float* out; unsigned char* ws; int ph_lo, ph_hi; };
enum { I_XP = 0, I_XS, I_CK, I_CV, I_CKI, I_SH, I_SLC, I_SCC, I_SPL, I_WIN, I_LCW, I_LCB, I_LWR, I_LBR, I_LWI, I_LBI, I_LAM, I_CCW, I_CCB, I_CLG, I_CLB, I_PW, I_PSC, I_WBR, I_WOUT,
       I_LN1G, I_LN1B, I_WQ, I_SUBK, I_PU, I_PV, I_LN2G, I_LN2B };

__device__ __forceinline__ Args load_args() {
    typedef const __attribute__((address_space(4))) unsigned long long* kp_t;
    kp_t kp = (kp_t)__builtin_amdgcn_kernarg_segment_ptr(); asm volatile("" : "+s"(kp));
    Args a;
    typedef __attribute__((address_space(1))) float* gf_t;
#pragma unroll
    for (int i = 0; i < 33; ++i) a.in[i] = (const float*)(gf_t)kp[i];
    a.out = (float*)(gf_t)kp[33]; a.ws = (unsigned char*)(__attribute__((address_space(1))) unsigned char*)kp[34]; a.ph_lo = 0; a.ph_hi = 0;
    return a;
}

struct RowI { int b, t, tail, pos; };
__device__ __forceinline__ RowI rowinfo(int r) { RowI o; if (r < MP) { o.b = r >> 12; o.t = r & 4095; o.tail = 4095 - o.t; o.pos = o.t; } else { const int rr = r - MP; o.b = rr >> 6; o.t = rr & 63; o.tail = 63 - o.t; o.pos = PAST + o.t; } return o; }

__device__ __forceinline__ int win_src(int j) {
    if (j < 2048) return j;
    if (j < 4096) { const int tt = (j - 2048) >> 8, w = (j - 2048) & 255; return w < 128 ? 2048 + 128 * tt + w : 3072 + 128 * tt + (w - 128); }
    if (j < 6216) return j;
    if (j < 6400) return -1;
    if (j < 7424) return 6216 + (j - 6400);
    return 7240 + (j - 7424);
}

struct EpiWin {
    static constexpr bool PERM = false;
    unsigned char* ws; float* out; int l;
    __device__ __forceinline__ void operator()(const f32x4 (&acc)[2][2][4][2], const pg8::Unit& u, int wr, int wc, int fr, int fq) const {
        asm volatile("" : "+v"(fr), "+v"(fq));
        const int pn = u.pn; const int rbase = u.pm * 256 + wr * 64 + fr; const bool samp = rbase >= MP;
        const int cl = wc * 32 + 4 * fq;
        if (pn < 4) {
            bf16_t* ZA = (bf16_t*)(ws + WS_ZA);
#pragma unroll
            for (int ai = 0; ai < 2; ++ai)
#pragma unroll
                for (int m = 0; m < 4; ++m) { const int r = rbase + ai * 128 + m * 16; const RowI ri = rowinfo(r);
#pragma unroll
                    for (int bj = 0; bj < 2; ++bj)
#pragma unroll
                        for (int n = 0; n < 2; ++n) { const f32x4 v = acc[ai][bj][m][n]; const int c = pn * 256 + bj * 128 + cl + n * 16;
                            *(u32x2*)(ZA + (size_t)r * WL + c) = (u32x2){pk2(v[0], v[1]), pk2(v[2], v[3])};
                            if (ri.tail < 3) { float* o = samp ? out + O_LCS + ((size_t)(l * DB + ri.b) * 3 + (2 - ri.tail)) * WL : out + O_LCP + ((size_t)(l * 2 + ri.b) * 3 + (2 - ri.tail)) * WL; *(f32x4*)(o + c) = v; } } }
        } else if (pn < 8) {
            bf16_t* GZ = (bf16_t*)(ws + WS_GZ);
#pragma unroll
            for (int ai = 0; ai < 2; ++ai)
#pragma unroll
                for (int m = 0; m < 4; ++m) { const int r = rbase + ai * 128 + m * 16;
#pragma unroll
                    for (int bj = 0; bj < 2; ++bj)
#pragma unroll
                        for (int n = 0; n < 2; ++n) { const f32x4 v = acc[ai][bj][m][n]; const int c = (pn - 4) * 256 + bj * 128 + cl + n * 16;
                            *(u32x2*)(GZ + (size_t)r * WL + c) = (u32x2){pk2(gelu_tanh(v[0]), gelu_tanh(v[1])), pk2(gelu_tanh(v[2]), gelu_tanh(v[3]))}; } }
        } else if (pn < 16) {
            bf16_t* GLU = (bf16_t*)(ws + WS_GLU);
#pragma unroll
            for (int ai = 0; ai < 2; ++ai)
#pragma unroll
                for (int m = 0; m < 4; ++m) { const int r = rbase + ai * 128 + m * 16; const RowI ri = rowinfo(r);
#pragma unroll
                    for (int n = 0; n < 2; ++n) { const f32x4 a = acc[ai][0][m][n], g = acc[ai][1][m][n]; f32x4 v;
#pragma unroll
                        for (int j = 0; j < 4; ++j) v[j] = a[j] * sigmoidf_(g[j]);
                        const int c = (pn - 8) * 128 + cl + n * 16;
                        *(u32x2*)(GLU + (size_t)r * WL + c) = (u32x2){pk2(v[0], v[1]), pk2(v[2], v[3])};
                        if (ri.tail < 30) { float* o = samp ? out + O_CCS + ((size_t)(l * DB + ri.b) * 30 + (29 - ri.tail)) * WL : out + O_CCP + ((size_t)(l * 2 + ri.b) * 30 + (29 - ri.tail)) * WL; *(f32x4*)(o + c) = v; } } }
        } else if (pn < 22) {
            const float* cosq = (const float*)(ws + WS_ROPE); const float* sinq = cosq + 4096 * 16;
            f32x4 csa[2][4], sna[2][4];
#pragma unroll
            for (int ai = 0; ai < 2; ++ai)
#pragma unroll
                for (int m = 0; m < 4; ++m) { const RowI ri = rowinfo(rbase + ai * 128 + m * 16);
                    csa[ai][m] = (f32x4){1.f, 1.f, 1.f, 1.f}; sna[ai][m] = (f32x4){0.f, 0.f, 0.f, 0.f};
                    if (wc == 0 && pn != 21) { csa[ai][m] = *(const f32x4*)(cosq + ri.pos * 16 + 4 * fq); sna[ai][m] = *(const f32x4*)(sinq + ri.pos * 16 + 4 * fq); } }
#pragma unroll
            for (int ai = 0; ai < 2; ++ai)
#pragma unroll
                for (int m = 0; m < 4; ++m) { const int r = rbase + ai * 128 + m * 16; const RowI ri = rowinfo(r);
                    const f32x4 cs = csa[ai][m], sn = sna[ai][m];
#pragma unroll
                    for (int bj = 0; bj < 2; ++bj) { f32x4 v0 = acc[ai][bj][m][0], v1 = acc[ai][bj][m][1];
                        if (wc == 0 && pn != 21) { const f32x4 x1 = v0, x2 = v1; v0 = x1 * cs - x2 * sn; v1 = x2 * cs + x1 * sn; }
                        const int c = bj * 128 + cl;
                        if (pn < 20) { bf16_t* Q = (bf16_t*)(ws + WS_Q) + (size_t)r * WL + (pn - 16) * 256 + c;
                            *(u32x2*)(Q) = (u32x2){pk2(v0[0] * QSCALE, v0[1] * QSCALE), pk2(v0[2] * QSCALE, v0[3] * QSCALE)};
                            *(u32x2*)(Q + 16) = (u32x2){pk2(v1[0] * QSCALE, v1[1] * QSCALE), pk2(v1[2] * QSCALE, v1[3] * QSCALE)};
                        } else {
                            const bool isk = (pn == 20);
                            bf16_t* dst = samp ? (bf16_t*)(ws + (isk ? WS_KS : WS_VS)) + ((size_t)ri.b * SKS + PAST + ri.t) * 256 + c : (bf16_t*)(ws + (isk ? WS_KP : WS_VP)) + (size_t)r * 256 + c;
                            *(u32x2*)(dst) = (u32x2){pk2(v0[0], v0[1]), pk2(v0[2], v0[3])}; *(u32x2*)(dst + 16) = (u32x2){pk2(v1[0], v1[1]), pk2(v1[2], v1[3])};
                            float* o = samp ? out + (isk ? O_KS : O_VS) + ((size_t)(l * DB + ri.b) * DSQ + ri.t) * 256 + c : out + (isk ? O_KP : O_VP) + ((size_t)(l * 2 + ri.b) * SEQ + ri.t) * 256 + c;
                            *(f32x4*)(o) = v0; *(f32x4*)(o + 16) = v1; } } }
        } else if (pn < 25) {
            const float* cosi = (const float*)(ws + WS_ROPE) + 4096 * 32; const float* sini = cosi + 4096 * 8;
            const bool rot = (wc & 1) == 0;
            f32x4 csa[2][4], sna[2][4];
#pragma unroll
            for (int ai = 0; ai < 2; ++ai)
#pragma unroll
                for (int m = 0; m < 4; ++m) { const RowI ri = rowinfo(rbase + ai * 128 + m * 16);
                    csa[ai][m] = (f32x4){1.f, 1.f, 1.f, 1.f}; sna[ai][m] = (f32x4){0.f, 0.f, 0.f, 0.f};
                    if (rot) { csa[ai][m] = *(const f32x4*)(cosi + ri.pos * 8 + 4 * (fq & 1)); sna[ai][m] = *(const f32x4*)(sini + ri.pos * 8 + 4 * (fq & 1)); } }
#pragma unroll
            for (int ai = 0; ai < 2; ++ai)
#pragma unroll
                for (int m = 0; m < 4; ++m) { const int r = rbase + ai * 128 + m * 16; const RowI ri = rowinfo(r);
                    const f32x4 cs = csa[ai][m], sn = sna[ai][m];
#pragma unroll
                    for (int bj = 0; bj < 2; ++bj) { f32x4 v0 = acc[ai][bj][m][0]; const f32x4 v1 = acc[ai][bj][m][1];
                        if (rot) { f32x4 p;
#pragma unroll
                            for (int j = 0; j < 4; ++j) p[j] = shflx(v0[j], 32);
                            if (fq < 2) v0 = v0 * cs - p * sn; else v0 = v0 * cs + p * sn; }
                        if (pn < 24) { bf16_t* QI = (bf16_t*)(ws + WS_QI) + (size_t)r * 512 + (pn - 22) * 256 + bj * 128 + cl;
                            *(u32x2*)(QI) = (u32x2){pk2(v0[0], v0[1]), pk2(v0[2], v0[3])}; *(u32x2*)(QI + 16) = (u32x2){pk2(v1[0], v1[1]), pk2(v1[2], v1[3])};
                        } else if (bj == 0) {
                            if (wc < 2) { bf16_t* dst = samp ? (bf16_t*)(ws + WS_KIS) + ((size_t)ri.b * SKS + PAST + ri.t) * 64 + cl : (bf16_t*)(ws + WS_KIP) + (size_t)r * 64 + cl;
                                *(u32x2*)(dst) = (u32x2){pk2(v0[0], v0[1]), pk2(v0[2], v0[3])}; *(u32x2*)(dst + 16) = (u32x2){pk2(v1[0], v1[1]), pk2(v1[2], v1[3])};
                                float* o = samp ? out + O_KIS + ((size_t)(l * DB + ri.b) * DSQ + ri.t) * 64 + cl : out + O_KIP + ((size_t)(l * 2 + ri.b) * SEQ + ri.t) * 64 + cl;
                                *(f32x4*)(o) = v0; *(f32x4*)(o + 16) = v1;
                            } else if (wc == 2 && fq < 2) { *(f32x4*)((float*)(ws + WS_WI) + (size_t)r * 8 + 4 * fq) = acc[ai][0][m][0]; } } } }
        } else if (pn < 29) {
            bf16_t* ZP = (bf16_t*)(ws + WS_ZP);
#pragma unroll
            for (int ai = 0; ai < 2; ++ai)
#pragma unroll
                for (int m = 0; m < 4; ++m) { const int r = rbase + ai * 128 + m * 16; const RowI ri = rowinfo(r);
#pragma unroll
                    for (int bj = 0; bj < 2; ++bj)
#pragma unroll
                        for (int n = 0; n < 2; ++n) { const f32x4 v = acc[ai][bj][m][n]; const int c = (pn - 25) * 256 + bj * 128 + cl + n * 16;
                            *(u32x2*)(ZP + (size_t)r * WL + c) = (u32x2){pk2(v[0], v[1]), pk2(v[2], v[3])};
                            if (ri.tail < 15) { float* o = samp ? out + O_PS + ((size_t)(l * DB + ri.b) * 15 + (14 - ri.tail)) * WL : out + O_PP + ((size_t)(l * 2 + ri.b) * 15 + (14 - ri.tail)) * WL; *(f32x4*)(o + c) = v; } } }
        } else {
            unsigned char* GT = ws + WS_GATES;
#pragma unroll
            for (int ai = 0; ai < 2; ++ai)
#pragma unroll
                for (int m = 0; m < 4; ++m) { const int r = rbase + ai * 128 + m * 16;
#pragma unroll
                    for (int bj = 0; bj < 2; ++bj)
#pragma unroll
                        for (int n = 0; n < 2; ++n) { const f32x4 v = acc[ai][bj][m][n]; const int c = (pn - 29) * 256 + bj * 128 + cl + n * 16;
                            *(unsigned*)(GT + (size_t)r * 8192 + c) = pk4_u8(sig255(v[0]), sig255(v[1]), sig255(v[2]), sig255(v[3])); } }
        }
    }
};

struct EpiGates {
    static constexpr bool PERM = false;
    unsigned char* ws;
    __device__ __forceinline__ void operator()(const f32x4 (&acc)[2][2][4][2], const pg8::Unit& u, int wr, int wc, int fr, int fq) const {
        asm volatile("" : "+v"(fr), "+v"(fq));
        const int rbase = u.pm * 256 + wr * 64 + fr, cl = wc * 32 + 4 * fq; constexpr float GSC = 1.0f / 64.0f;
        unsigned char* GT = ws + WS_GATES;
#pragma unroll
        for (int ai = 0; ai < 2; ++ai)
#pragma unroll
            for (int m = 0; m < 4; ++m) { const int r = rbase + ai * 128 + m * 16;
#pragma unroll
                for (int bj = 0; bj < 2; ++bj)
#pragma unroll
                    for (int n = 0; n < 2; ++n) { const f32x4 v = acc[ai][bj][m][n]; const int c = u.pn * 256 + bj * 128 + cl + n * 16;
                        *(unsigned*)(GT + (size_t)r * 8192 + c) = pk4_u8(sig255(v[0] * GSC), sig255(v[1] * GSC), sig255(v[2] * GSC), sig255(v[3] * GSC)); } }
    }
};

struct EpiPool {
    static constexpr bool PERM = true;
    unsigned char* Y3; const float* scale;
    __device__ __forceinline__ void operator()(const f32x4 (&acc)[2][2][4][2], const pg8::Unit& u, int wr, int wc, int fr, int fq) const {
        asm volatile("" : "+v"(fr), "+v"(fq));
        const int row0 = u.pm * 256 + wr * 64 + fr, col0 = u.z * 256 + wc * 32 + 8 * fq;
        f32x4 sc0[2], sc1[2];
#pragma unroll
        for (int bj = 0; bj < 2; ++bj) { sc0[bj] = *(const f32x4*)(scale + col0 + bj * 128); sc1[bj] = *(const f32x4*)(scale + col0 + bj * 128 + 4); }
#pragma unroll
        for (int bj = 0; bj < 2; ++bj) { const f32x4 s0 = sc0[bj], s1 = sc1[bj];
#pragma unroll
            for (int ai = 0; ai < 2; ++ai)
#pragma unroll
                for (int m = 0; m < 4; ++m) { const f32x4 v0 = acc[ai][bj][m][0] * s0, v1 = acc[ai][bj][m][1] * s1;
                    *(u32x2*)(Y3 + (size_t)(row0 + ai * 128 + m * 16) * WL + col0 + bj * 128) = (u32x2){pk4_fp8(v0), pk4_fp8(v1)}; } }
    }
};

struct EpiGate {
    static constexpr bool PERM = true;
    bf16_t* PG; const unsigned char* GT;
    __device__ __forceinline__ void operator()(const f32x4 (&acc)[2][2][4][2], const pg8::Unit& u, int wr, int wc, int fr, int fq) const {
        asm volatile("" : "+v"(fr), "+v"(fq));
        const int row0 = u.pm * 256 + wr * 64 + fr, col0 = u.pn * 256 + wc * 32 + 8 * fq;
        u32x2 gg[2][4][2];
#pragma unroll
        for (int ai = 0; ai < 2; ++ai)
#pragma unroll
            for (int m = 0; m < 4; ++m)
#pragma unroll
                for (int bj = 0; bj < 2; ++bj) gg[ai][m][bj] = *(const u32x2*)(GT + (size_t)(row0 + ai * 128 + m * 16) * 8192 + u.z * 2048 + col0 + bj * 128);
#pragma unroll
        for (int ai = 0; ai < 2; ++ai)
#pragma unroll
            for (int m = 0; m < 4; ++m) { const int r = row0 + ai * 128 + m * 16;
#pragma unroll
                for (int bj = 0; bj < 2; ++bj) { const u32x2 g = gg[ai][m][bj];
                    const f32x4 v0 = acc[ai][bj][m][0] * (1.0f / 32.0f), v1 = acc[ai][bj][m][1] * (1.0f / 32.0f);
                    u32x4 w; w.x = pk2(v0[0] * gate_u8(g.x, 0), v0[1] * gate_u8(g.x, 1)); w.y = pk2(v0[2] * gate_u8(g.x, 2), v0[3] * gate_u8(g.x, 3)); w.z = pk2(v1[0] * gate_u8(g.y, 0), v1[1] * gate_u8(g.y, 1)); w.w = pk2(v1[2] * gate_u8(g.y, 2), v1[3] * gate_u8(g.y, 3));
                    *(u32x4*)(PG + ((size_t)u.z * M + r) * D + col0 + bj * 128) = w; } }
    }
};

struct EpiOut {
    static constexpr bool PERM = false;
    const float* xp; const float* xs; const bf16_t* xb; bf16_t* pre;
    __device__ __forceinline__ void operator()(const f32x4 (&acc)[2][2][4][2], const pg8::Unit& u, int wr, int wc, int fr, int fq) const {
        asm volatile("" : "+v"(fr), "+v"(fq));
        const int row0 = u.pm * 256 + wr * 64 + fr, col0 = u.pn * 256 + wc * 32 + 4 * fq;
        if (xb) {
            u32x2 xw[2][4][2][2];
#pragma unroll
            for (int ai = 0; ai < 2; ++ai)
#pragma unroll
                for (int m = 0; m < 4; ++m)
#pragma unroll
                    for (int bj = 0; bj < 2; ++bj)
#pragma unroll
                        for (int n = 0; n < 2; ++n) xw[ai][m][bj][n] = *(const u32x2*)(xb + (size_t)(row0 + ai * 128 + m * 16) * D + col0 + bj * 128 + n * 16);
#pragma unroll
            for (int ai = 0; ai < 2; ++ai)
#pragma unroll
                for (int m = 0; m < 4; ++m) { const int r = row0 + ai * 128 + m * 16;
#pragma unroll
                    for (int bj = 0; bj < 2; ++bj)
#pragma unroll
                        for (int n = 0; n < 2; ++n) { const int c = col0 + bj * 128 + n * 16; const u32x2 w = xw[ai][m][bj][n];
                            const f32x4 y = (f32x4){bflo(w.x), bfhi(w.x), bflo(w.y), bfhi(w.y)} * ALPHA + acc[ai][bj][m][n];
                            *(u32x2*)(pre + (size_t)r * D + c) = (u32x2){pk2(y[0], y[1]), pk2(y[2], y[3])}; } }
        } else {
            const float* xrow = (u.pm * 256 < MP) ? xp + (size_t)row0 * D : xs + (size_t)(row0 - MP) * D;
#pragma unroll
            for (int ai = 0; ai < 2; ++ai) {
                f32x4 xv[4][2][2];
#pragma unroll
                for (int m = 0; m < 4; ++m)
#pragma unroll
                    for (int bj = 0; bj < 2; ++bj)
#pragma unroll
                        for (int n = 0; n < 2; ++n) xv[m][bj][n] = *(const f32x4*)(xrow + (size_t)(ai * 128 + m * 16) * D + col0 + bj * 128 + n * 16);
#pragma unroll
                for (int m = 0; m < 4; ++m) { const int r = row0 + ai * 128 + m * 16;
#pragma unroll
                    for (int bj = 0; bj < 2; ++bj)
#pragma unroll
                        for (int n = 0; n < 2; ++n) { const int c = col0 + bj * 128 + n * 16;
                            const f32x4 y = xv[m][bj][n] * ALPHA + acc[ai][bj][m][n];
                            *(u32x2*)(pre + (size_t)r * D + c) = (u32x2){pk2(y[0], y[1]), pk2(y[2], y[3])}; } }
            }
        }
    }
};

struct EpiQ {
    static constexpr bool PERM = true;
    bf16_t* QP;
    __device__ __forceinline__ void operator()(const f32x4 (&acc)[2][2][4][2], const pg8::Unit& u, int wr, int wc, int fr, int fq) const {
        asm volatile("" : "+v"(fr), "+v"(fq));
        const int row0 = u.pm * 256 + wr * 64 + fr, col0 = u.pn * 256 + wc * 32 + 8 * fq;
#pragma unroll
        for (int ai = 0; ai < 2; ++ai)
#pragma unroll
            for (int m = 0; m < 4; ++m)
#pragma unroll
                for (int bj = 0; bj < 2; ++bj) { const f32x4 v0 = acc[ai][bj][m][0], v1 = acc[ai][bj][m][1];
                    u32x4 w; w.x = pk2(v0[0], v0[1]); w.y = pk2(v0[2], v0[3]); w.z = pk2(v1[0], v1[1]); w.w = pk2(v1[2], v1[3]);
                    *(u32x4*)(QP + (size_t)(row0 + ai * 128 + m * 16) * D + col0 + bj * 128) = w; }
    }
};

struct PoolOrder {
    int G, c;
    __device__ bool next(int i, pg8::Unit& u) const { const int L = i * G + c; if (L >= 160) return false; u.pm = L >> 2; u.z = L & 3; u.pn = 0;
        u.aoff = ((size_t)u.pm * 256 * WL + u.z * 256) * 2; u.boff = (size_t)u.z * 256 * 256 * 2; return true; }
};
struct BranchOrder {
    int G, c;
    __device__ bool next(int i, pg8::Unit& u) const { const int L = i * G + c; if (L >= 1280) return false; const int z = L / 320, t = L % 320; u.z = z; u.pm = t % 40; u.pn = t / 40;
        u.aoff = ((size_t)z * M + (size_t)u.pm * 256) * WL; u.boff = ((size_t)z * 2048 + (size_t)u.pn * 256) * WL; return true; }
};
struct Frame { LAS unsigned char* lds; unsigned char* ws; unsigned* ctl; int tid, lane, wave, G, bid; };

struct ItemQ { int nxt; };
__device__ __forceinline__ int q_first(const Frame& F, int cw, ItemQ& q) {
    volatile LAS int* slot = (volatile LAS int*)(F.lds + LDS_MISC + 64);
    const bool me = (F.wave == 0 && fresh_lane() == 0);
    __syncthreads();
    if (me) { *slot = (int)__hip_atomic_fetch_add(F.ctl + cw, 1u, __ATOMIC_RELAXED, __HIP_MEMORY_SCOPE_AGENT); }
    __syncthreads();
    const int cur = *slot;
    q.nxt = 0; if (me) q.nxt = (int)__hip_atomic_fetch_add(F.ctl + cw, 1u, __ATOMIC_RELAXED, __HIP_MEMORY_SCOPE_AGENT);
    return cur;
}
__device__ __forceinline__ int q_block(const Frame& F, int cw) {
    volatile LAS int* slot = (volatile LAS int*)(F.lds + LDS_MISC + 64);
    __syncthreads();
    if (F.wave == 0 && fresh_lane() == 0) *slot = (int)__hip_atomic_fetch_add(F.ctl + cw, 1u, __ATOMIC_RELAXED, __HIP_MEMORY_SCOPE_AGENT);
    __syncthreads();
    return *slot;
}
__device__ __forceinline__ int q_next(const Frame& F, int cw, ItemQ& q) {
    volatile LAS int* slot = (volatile LAS int*)(F.lds + LDS_MISC + 64);
    const bool me = (F.wave == 0 && fresh_lane() == 0);
    __syncthreads();
    if (me) { *slot = q.nxt; q.nxt = (int)__hip_atomic_fetch_add(F.ctl + cw, 1u, __ATOMIC_RELAXED, __HIP_MEMORY_SCOPE_AGENT); }
    __syncthreads();
    return *slot;
}
constexpr int CW_ITEM = 8192;

template <class MapFn>
__device__ __forceinline__ void transpose_mat(const Frame& F, const float* W, int ldw, bf16_t* WT, int K, int Ndst, MapFn map) {
    LAS float* scr = (LAS float*)(F.lds + F.wave * 16640);
    const int gw = F.bid * NWAVES + F.wave, NGW = F.G * NWAVES, lane = F.lane;
    const int nblk = Ndst / 64, nitems = (K / 64) * nblk;
    const int cq = lane & 15, rq = lane >> 4;
    for (int it = gw; it < nitems; it += NGW) {
        const int kb = it / nblk, nb = it % nblk, k0 = 64 * kb, n0 = 64 * nb;
        const int sc = map(n0 + 4 * cq);
        f32x4 v[16];
#pragma unroll
        for (int i = 0; i < 16; ++i) v[i] = sc >= 0 ? *(const f32x4*)(W + (size_t)(k0 + rq + 4 * i) * ldw + sc) : (f32x4){0.f, 0.f, 0.f, 0.f};
#pragma unroll
        for (int i = 0; i < 16; ++i) { const int kk = rq + 4 * i;
#pragma unroll
            for (int e = 0; e < 4; ++e) scr[(4 * cq + e) * 65 + kk] = v[i][e]; }
        asm volatile("s_waitcnt lgkmcnt(0)" ::: "memory");
        const int c8 = lane & 7;
#pragma unroll
        for (int j = 0; j < 8; ++j) { const int n = (lane >> 3) + 8 * j; const LAS float* s = scr + n * 65 + 8 * c8;
            u32x4 o; o.x = pk2(s[0], s[1]); o.y = pk2(s[2], s[3]); o.z = pk2(s[4], s[5]); o.w = pk2(s[6], s[7]);
            *(u32x4*)(WT + (size_t)(n0 + n) * K + k0 + 8 * c8) = o; }
        asm volatile("s_waitcnt lgkmcnt(0)" ::: "memory");
    }
}
__device__ __forceinline__ void transpose_mat8(const Frame& F, const float* W, int ldw, unsigned char* WT, int K, int Ndst, float wsc = 64.0f) {
    LAS float* scr = (LAS float*)(F.lds + F.wave * 16640);
    const int gw = F.bid * NWAVES + F.wave, NGW = F.G * NWAVES, lane = F.lane;
    const int nblk = Ndst / 64, nitems = (K / 64) * nblk;
    const int cq = lane & 15, rq = lane >> 4;
    for (int it = gw; it < nitems; it += NGW) {
        const int kb = it / nblk, nb = it % nblk, k0 = 64 * kb, n0 = 64 * nb;
        f32x4 v[16];
#pragma unroll
        for (int i = 0; i < 16; ++i) v[i] = *(const f32x4*)(W + (size_t)(k0 + rq + 4 * i) * ldw + n0 + 4 * cq);
#pragma unroll
        for (int i = 0; i < 16; ++i) { const int kk = rq + 4 * i;
#pragma unroll
            for (int e = 0; e < 4; ++e) scr[(4 * cq + e) * 65 + kk] = v[i][e] * wsc; }
        asm volatile("s_waitcnt lgkmcnt(0)" ::: "memory");
        const int c8 = lane & 7;
#pragma unroll
        for (int j = 0; j < 8; ++j) { const int n = (lane >> 3) + 8 * j; const LAS float* s = scr + n * 65 + 8 * c8;
            int w0 = 0, w1 = 0;
            w0 = __builtin_amdgcn_cvt_pk_fp8_f32(s[0], s[1], w0, false); w0 = __builtin_amdgcn_cvt_pk_fp8_f32(s[2], s[3], w0, true);
            w1 = __builtin_amdgcn_cvt_pk_fp8_f32(s[4], s[5], w1, false); w1 = __builtin_amdgcn_cvt_pk_fp8_f32(s[6], s[7], w1, true);
            *(u32x2*)(WT + (size_t)(n0 + n) * K + k0 + 8 * c8) = (u32x2){(unsigned)w0, (unsigned)w1}; }
        asm volatile("s_waitcnt lgkmcnt(0)" ::: "memory");
    }
}
struct MapId { __device__ __forceinline__ int operator()(int j) const { return j; } };
struct MapWin { __device__ __forceinline__ int operator()(int j) const { return win_src(j); } };

__device__ __forceinline__ void cvt_rows(const Frame& F, const float* src, bf16_t* dst, size_t n4, int nb, size_t sbs, size_t dbs, unsigned char* dst8 = nullptr) {
    const size_t total = n4 * nb, stride = (size_t)F.G * NTHREADS;
    size_t i = (size_t)F.bid * NTHREADS + F.tid;
    for (; i + 7 * stride < total; i += 8 * stride) {
        f32x4 v[8]; size_t off[8];
#pragma unroll
        for (int u = 0; u < 8; ++u) { const size_t ii = i + u * stride, b = ii / n4, j = ii - b * n4; v[u] = *(const f32x4*)(src + b * sbs + 4 * j); off[u] = b * dbs + 4 * j; }
#pragma unroll
        for (int u = 0; u < 8; ++u) { *(u32x2*)(dst + off[u]) = (u32x2){pk2(v[u][0], v[u][1]), pk2(v[u][2], v[u][3])}; if (dst8) *(unsigned*)(dst8 + off[u]) = pk4_fp8(v[u]); }
    }
    for (; i < total; i += stride) { const size_t b = i / n4, j = i - b * n4;
        const f32x4 v = *(const f32x4*)(src + b * sbs + 4 * j); *(u32x2*)(dst + b * dbs + 4 * j) = (u32x2){pk2(v[0], v[1]), pk2(v[2], v[3])}; if (dst8) *(unsigned*)(dst8 + b * dbs + 4 * j) = pk4_fp8(v); }
}
__device__ __forceinline__ void cvt_table_fp8(const Frame& F, const float* src, unsigned char* dst, float* scl, int nrows) {
    const int lane = F.lane;
    for (int r = F.bid * NWAVES + F.wave; r < nrows; r += F.G * NWAVES) {
        f32x4 v[8]; float mx = 0.f;
#pragma unroll
        for (int j = 0; j < 2; ++j)
#pragma unroll
            for (int q = 0; q < 4; ++q) { v[4 * j + q] = *(const f32x4*)(src + (size_t)r * D + 1024 * j + 16 * lane + 4 * q);
                mx = fmaxf(mx, fmaxf(fmaxf(fabsf(v[4 * j + q][0]), fabsf(v[4 * j + q][1])), fmaxf(fabsf(v[4 * j + q][2]), fabsf(v[4 * j + q][3])))); }
        mx = wave_max_dpp(mx);
        const float sc = (mx > 0.f) ? mx * (1.0f / 448.0f) : 1.0f, inv = 1.0f / sc;
#pragma unroll
        for (int j = 0; j < 2; ++j) { u32x4 o;
#pragma unroll
            for (int q = 0; q < 4; ++q) { const f32x4 x = v[4 * j + q] * inv; int w = __builtin_amdgcn_cvt_pk_fp8_f32(x[0], x[1], 0, false); w = __builtin_amdgcn_cvt_pk_fp8_f32(x[2], x[3], w, true); o[q] = (unsigned)w; }
            *(u32x4*)(dst + (size_t)r * D + 1024 * j + 16 * lane) = o; }
        if (lane == 0) scl[r] = sc;
    }
}
constexpr size_t WS_V4S = WS_V + (size_t)2 * NEXP * 1024;
__device__ __forceinline__ void cvt_table_fp4(const Frame& F, const float* src, unsigned char* dst, unsigned char* sce, int nrows) {
    const int lane = F.lane;
    for (int r = F.bid * NWAVES + F.wave; r < nrows; r += F.G * NWAVES) {
        f32x4 v[8]; float mx = 0.f;
#pragma unroll
        for (int q = 0; q < 8; ++q) { v[q] = *(const f32x4*)(src + (size_t)r * D + 32 * lane + 4 * q);
            mx = fmaxf(mx, fmaxf(fmaxf(fabsf(v[q][0]), fabsf(v[q][1])), fmaxf(fabsf(v[q][2]), fabsf(v[q][3])))); }
        unsigned e = ((__float_as_uint(mx * (1.0f / 6.0f)) + 0x7FFFFFu) >> 23) & 0xFFu;
        e = e < 1u ? 1u : (e > 253u ? 253u : e);
        const float inv = __uint_as_float((254u - e) << 23);
        u32x4 o;
#pragma unroll
        for (int i = 0; i < 4; ++i) { unsigned w = 0u;
#pragma unroll
            for (int k = 0; k < 8; ++k) { const float x = v[2 * i + (k >> 2)][k & 3]; const float y = fabsf(x) * inv;
                const unsigned code = (y > 0.25f) + (y >= 0.75f) + (y > 1.25f) + (y >= 1.75f) + (y > 2.5f) + (y >= 3.5f) + (y > 5.0f);
                w |= (code | ((__float_as_uint(x) >> 31) << 3)) << (4 * k); }
            o[i] = w; }
        *(u32x4*)(dst + (size_t)r * 1024 + 16 * lane) = o;
        sce[(size_t)r * 64 + lane] = (unsigned char)e;
    }
}
__device__ __forceinline__ void convert_cache(const Frame& F, int l) {
    const Args A = load_args();
    cvt_rows(F, A.in[I_CK] + (size_t)l * DB * PAST * 256, (bf16_t*)(F.ws + WS_KS), (size_t)PAST * 64, DB, (size_t)PAST * 256, (size_t)SKS * 256);
    cvt_rows(F, A.in[I_CV] + (size_t)l * DB * PAST * 256, (bf16_t*)(F.ws + WS_VS), (size_t)PAST * 64, DB, (size_t)PAST * 256, (size_t)SKS * 256);
    cvt_rows(F, A.in[I_CKI] + (size_t)l * DB * PAST * 64, (bf16_t*)(F.ws + WS_KIS), (size_t)PAST * 16, DB, (size_t)PAST * 64, (size_t)SKS * 64);
}
__device__ __forceinline__ void prep_a(const Frame& F, int l) {
    const Args A = load_args(); unsigned char* ws = F.ws;
    transpose_mat(F, A.in[I_WIN] + (size_t)l * D * NPROJ, NPROJ, (bf16_t*)(ws + WS_WIN) + (size_t)l * NPAD * D, D, NT_BF * 256, MapWin());
    transpose_mat8(F, A.in[I_WIN] + (size_t)l * D * NPROJ + 7240, NPROJ, ws + WS_WIN8 + (size_t)l * 8192 * D, D, 8192);
}
__device__ __forceinline__ void prep_a_bf(const Frame& F, int l) { const Args A = load_args(); unsigned char* ws = F.ws;
    transpose_mat(F, A.in[I_WIN] + (size_t)l * D * NPROJ, NPROJ, (bf16_t*)(ws + WS_WIN) + (size_t)l * NPAD * D, D, NT_BF * 256, MapWin()); }
__device__ __forceinline__ void prep_a_f8(const Frame& F, int l) { const Args A = load_args(); unsigned char* ws = F.ws;
    transpose_mat8(F, A.in[I_WIN] + (size_t)l * D * NPROJ + 7240, NPROJ, ws + WS_WIN8 + (size_t)l * 8192 * D, D, 8192); }
__device__ __forceinline__ void prep_b(const Frame& F, int l) {
    const Args A = load_args(); unsigned char* ws = F.ws;
    for (int z = 0; z < 4; ++z) transpose_mat8(F, A.in[I_WBR] + (size_t)(l * 4 + z) * WL * D, D, ws + WS_WBR + (size_t)(l * 4 + z) * D * WL, WL, D, 32.0f);
    transpose_mat(F, A.in[I_WOUT] + (size_t)l * D * D, D, (bf16_t*)(ws + WS_WOUT) + (size_t)l * D * D, D, D, MapId());
    transpose_mat(F, A.in[I_WQ] + (size_t)l * D * D, D, (bf16_t*)(ws + WS_WQ) + (size_t)l * D * D, D, D, MapId());
    for (int g = 0; g < 4; ++g) transpose_mat(F, A.in[I_PW] + (size_t)(l * 4 + g) * 256 * 256, 256, (bf16_t*)(ws + WS_POOLT) + (size_t)(l * 4 + g) * 256 * 256, 256, 256, MapId());
    for (int n = 0; n < 16; ++n) { transpose_mat(F, A.in[I_LWR] + (size_t)(l * 16 + n) * 4096, 64, (bf16_t*)(ws + WS_LRUW) + (size_t)((l * 2 + 0) * 16 + n) * 4096, 64, 64, MapId());
                                   transpose_mat(F, A.in[I_LWI] + (size_t)(l * 16 + n) * 4096, 64, (bf16_t*)(ws + WS_LRUW) + (size_t)((l * 2 + 1) * 16 + n) * 4096, 64, 64, MapId()); }
    cvt_rows(F, A.in[I_SUBK] + (size_t)l * 8 * 2 * 128 * 128, (bf16_t*)(ws + WS_SK) + (size_t)l * 8 * 2 * 128 * 128, (size_t)8 * 2 * 128 * 128 / 4, 1, 0, 0);
}
__device__ __forceinline__ void prep_u(const Frame& F, int l) {
    const Args A = load_args(); unsigned char* ws = F.ws;
    cvt_table_fp4(F, A.in[I_PU] + (size_t)l * NEXP * D, ws + WS_U + (size_t)l * NEXP * 1024, ws + WS_U + (size_t)2 * NEXP * 1024 + (size_t)l * NEXP * 64, NEXP);
}
__device__ __forceinline__ void prep_c(const Frame& F, int l) {
    const Args A = load_args(); unsigned char* ws = F.ws;
    cvt_table_fp4(F, A.in[I_PV] + (size_t)l * NEXP * D, ws + WS_V + (size_t)l * NEXP * 1024, ws + WS_V4S + (size_t)l * NEXP * 64, NEXP);
}
__device__ __forceinline__ void p0_prologue(const Frame& F) {
    unsigned char* ws = F.ws;
    prep_a(F, 0);
    { const Args A = load_args();
    cvt_rows(F, A.in[I_XP], (bf16_t*)(ws + WS_XB), (size_t)MP * D / 4, 1, 0, 0, ws + WS_XB8);
    cvt_rows(F, A.in[I_XS], (bf16_t*)(ws + WS_XB) + (size_t)MP * D, (size_t)MS * D / 4, 1, 0, 0, ws + WS_XB8 + (size_t)MP * D);
    }
    float* rope = (float*)(ws + WS_ROPE);
    for (int i = F.bid * NTHREADS + F.tid; i < 4096 * 24; i += F.G * NTHREADS) {
        const int pos = i / 24, k = i % 24; float inv, s, c;
        if (k < 16) { inv = powf(500000.0f, -(float)k / 16.0f); sincosf((float)pos * inv, &s, &c); rope[pos * 16 + k] = c; rope[4096 * 16 + pos * 16 + k] = s; }
        else { const int kk = k - 16; inv = powf(500000.0f, -(float)kk / 8.0f); sincosf((float)pos * inv, &s, &c); rope[4096 * 32 + pos * 8 + kk] = c; rope[4096 * 40 + pos * 8 + kk] = s; }
    }
}

__device__ __forceinline__ unsigned ord_key(unsigned u) { return (u & 0x80000000u) ? ~u : (u | 0x80000000u); }
__device__ __forceinline__ int wave_sum_i(int v) {
#pragma unroll
    for (int o = 1; o < 64; o <<= 1) v += shflx_i(v, o);
    return v;
}
__device__ __forceinline__ int wave_sum_i_dpp(int v) {
#define DPP_ADDI(ctrl, rmask) v += __builtin_amdgcn_update_dpp(0, v, ctrl, rmask, 0xF, false)
    DPP_ADDI(0xB1, 0xF); DPP_ADDI(0x4E, 0xF); DPP_ADDI(0x141, 0xF); DPP_ADDI(0x140, 0xF); DPP_ADDI(0x142, 0xA); DPP_ADDI(0x143, 0xC);
#undef DPP_ADDI
    return __builtin_amdgcn_readlane(v, 63);
}
constexpr int CW_SCD = 65536;
__device__ __forceinline__ int sel_uid(int samp, int b, int c) { return samp ? 128 + b : b * 64 + c; }
__device__ __forceinline__ int sel_nchunks(int samp, int c) { return samp ? 5 : ((c + 1 + 7) >> 3); }

__device__ __forceinline__ void score_item(const Frame& F, int l, int samp, int b, int c, int kc) {
    int tid = F.tid, lane = F.lane; const int wave = F.wave; asm volatile("" : "+v"(tid), "+v"(lane));
    __attribute__((address_space(1))) unsigned char* wsl_ = (__attribute__((address_space(1))) unsigned char*)F.ws; asm volatile("" : "+s"(wsl_)); unsigned char* ws = (unsigned char*)wsl_;
    const int r0 = samp ? MP + b * 64 : b * SEQ + c * 64;
    const int L = samp ? SKS : 64 * (c + 1);
    const int k0 = 512 * kc, k1 = (k0 + 512 < L) ? k0 + 512 : L;
    const bf16_t* KI = samp ? (const bf16_t*)(ws + WS_KIS) + (size_t)b * SKS * 64 : (const bf16_t*)(ws + WS_KIP) + (size_t)b * SEQ * 64;
    unsigned* SC = (unsigned*)(ws + WS_SC) + (size_t)r0 * 4096;
    const Args A = load_args(); const float* CKI = A.in[I_CKI] + (size_t)(l * DB + b) * PAST * 64;
    LAS unsigned char* QiL = F.lds;
    LAS float* WIl = (LAS float*)(F.lds + 66560);
    const bf16_t* QI = (const bf16_t*)(ws + WS_QI) + (size_t)r0 * 512;
    const int rl = lane & 31, h = lane >> 5;
    const int kbA = (k0 >> 5) + wave, kbB = kbA + NWAVES, nkb = (k1 >> 5);
    u32x4 raw[2][8];
#pragma unroll
    for (int u = 0; u < 2; ++u) { const int kb = u ? kbB : kbA; if (kb < nkb) { const int key = 32 * kb + rl;
        if (samp && key < PAST) { const float* kp = CKI + (size_t)key * 64 + 8 * h;
#pragma unroll
            for (int ks = 0; ks < 4; ++ks) { raw[u][2 * ks] = *(const u32x4*)(kp + 16 * ks); raw[u][2 * ks + 1] = *(const u32x4*)(kp + 16 * ks + 4); } }
        else {
#pragma unroll
            for (int ks = 0; ks < 4; ++ks) raw[u][ks] = *(const u32x4*)(KI + (size_t)key * 64 + 16 * ks + 8 * h); } } }
    { u32x4 st[8];
#pragma unroll
      for (int i = 0; i < 8; ++i) { const int id = tid + 512 * i, row = id >> 6, ch = id & 63; st[i] = *(const u32x4*)(QI + (size_t)row * 512 + ch * 8); }
      float wiv = ((const float*)(ws + WS_WI))[(size_t)r0 * 8 + tid];
      asm volatile("" : "+v"(st[0]), "+v"(st[1]), "+v"(st[2]), "+v"(st[3]), "+v"(st[4]), "+v"(st[5]), "+v"(st[6]), "+v"(st[7]), "+v"(wiv));
#pragma unroll
      for (int i = 0; i < 8; ++i) { const int id = tid + 512 * i, row = id >> 6, ch = id & 63; *(LAS u32x4*)(QiL + row * 1040 + ch * 16) = st[i]; }
      WIl[tid] = wiv; }
    __syncthreads();
#ifndef SCORE_REP
#define SCORE_REP 1
#endif
    for (int srep = 0; srep < SCORE_REP; ++srep)
#pragma unroll
    for (int u = 0; u < 2; ++u) { const int kb = u ? kbB : kbA; if (kb >= nkb) continue;
        const int key = 32 * kb + rl;
        bf16x8 bfr[4];
        if (samp && key < PAST) {
#pragma unroll
            for (int ks = 0; ks < 4; ++ks) { const u32x4 x0 = raw[u][2 * ks], x1 = raw[u][2 * ks + 1];
                union { bf16x8 v; unsigned w[4]; } u_; u_.w[0] = pk2(__uint_as_float(x0[0]), __uint_as_float(x0[1])); u_.w[1] = pk2(__uint_as_float(x0[2]), __uint_as_float(x0[3]));
                u_.w[2] = pk2(__uint_as_float(x1[0]), __uint_as_float(x1[1])); u_.w[3] = pk2(__uint_as_float(x1[2]), __uint_as_float(x1[3])); bfr[ks] = u_.v; }
        } else {
#pragma unroll
            for (int ks = 0; ks < 4; ++ks) { union { bf16x8 v; u32x4 w; } u_; u_.w = raw[u][ks]; bfr[ks] = u_.v; }
        }
#pragma unroll 1
        for (int qh = 0; qh < 2; ++qh) {
            f32x16 sc;
#pragma unroll
            for (int i = 0; i < 16; ++i) sc[i] = 0.f;
#pragma unroll 1
            for (int hh = 0; hh < 8; hh += 2) {
                f32x16 s0, s1;
#pragma unroll
                for (int i = 0; i < 16; ++i) { s0[i] = 0.f; s1[i] = 0.f; }
#pragma unroll
                for (int ks = 0; ks < 4; ++ks) { const LAS unsigned char* ap = QiL + (32 * qh + rl) * 1040 + (hh * 64 + 16 * ks + 8 * h) * 2;
                    const bf16x8 a0 = *(const LAS bf16x8*)(ap), a1 = *(const LAS bf16x8*)(ap + 128);
                    s0 = __builtin_amdgcn_mfma_f32_32x32x16_bf16(a0, bfr[ks], s0, 0, 0, 0); s1 = __builtin_amdgcn_mfma_f32_32x32x16_bf16(a1, bfr[ks], s1, 0, 0, 0); }
#pragma unroll
                for (int i = 0; i < 16; ++i) { const int q = 32 * qh + (i & 3) + 8 * (i >> 2) + 4 * h; const f32x2 w2 = *(const LAS f32x2*)(WIl + q * 8 + hh); sc[i] += w2[0] * fmaxf(s0[i], 0.f) + w2[1] * fmaxf(s1[i], 0.f); }
            }
#pragma unroll
            for (int i = 0; i < 16; ++i) { const int q = 32 * qh + (i & 3) + 8 * (i >> 2) + 4 * h; __hip_atomic_store(SC + (size_t)q * 4096 + key, __float_as_uint(sc[i]), __ATOMIC_RELAXED, __HIP_MEMORY_SCOPE_AGENT); }
        }
    }
    asm volatile("s_waitcnt vmcnt(0)" ::: "memory");
    __syncthreads();
    if (tid == 0) __hip_atomic_fetch_add(F.ctl + CW_SCD + 16 * (l * 160 + sel_uid(samp, b, c)), 1u, __ATOMIC_RELAXED, __HIP_MEMORY_SCOPE_AGENT);
}

#define SEL_FINISH(key, prefix, exact, myw) do { \
        asm volatile("" : "+v"(prefix));        \
        if (exact) { \
            _Pragma("unroll") for (int j = 0; j < 64; ++j) { const u64 ge = __ballot(key[j] >= prefix); if (lane == j) myw = ge; } \
        } else {        \
            int cgt = 0; \
            _Pragma("unroll") for (int j = 0; j < 64; ++j) cgt += (key[j] > prefix) ? 1 : 0; \
            cgt = wave_sum_i_dpp(cgt); \
            int rem = 256 - cgt; \
            _Pragma("unroll 1") for (int j = 0; j < 64; ++j) { \
                unsigned kj = 0u; \
                _Pragma("unroll") for (int jj = 0; jj < 64; ++jj) kj = (jj == j) ? key[jj] : kj; \
                const u64 gt = __ballot(kj > prefix), eq = __ballot(kj == prefix); \
                u64 take = 0ull; \
                if (eq != 0ull && rem > 0) { const int pc = __popcll(eq); if (pc <= rem) { take = eq; rem -= pc; } else { u64 t = eq; for (int z = 0; z < rem; ++z) t &= t - 1ull; take = eq ^ t; rem = 0; } } \
                if (lane == j) myw = gt | take; } } } while (0)
__device__ __forceinline__ void select_item(const Frame& F, int l, int samp, int b, int c, int qg) {
    int tid = F.tid, lane = F.lane; const int wave = F.wave; asm volatile("" : "+v"(tid), "+v"(lane));
    __attribute__((address_space(1))) unsigned char* wsl_ = (__attribute__((address_space(1))) unsigned char*)F.ws; asm volatile("" : "+s"(wsl_)); unsigned char* ws = (unsigned char*)wsl_;
    const int r0 = samp ? MP + b * 64 : b * SEQ + c * 64;
    const int L = samp ? SKS : 64 * (c + 1);
    const int nj = L >> 6;
    u64* SEL = (u64*)(ws + WS_SEL) + (size_t)r0 * 64;
    const int qA = qg * 16 + wave * 2, qB = qA + 1;
    u64 mywA = 0ull, mywB = 0ull;
    if (L <= 256) { mywA = (lane < nj) ? ~0ull : 0ull; mywB = mywA; }
    else {
        {
            unsigned* cw = F.ctl + CW_SCD + 16 * (l * 160 + sel_uid(samp, b, c)); const unsigned need = (unsigned)sel_nchunks(samp, c);
            unsigned spins = 0;
            while ((unsigned)__builtin_amdgcn_readfirstlane((int)__hip_atomic_load(cw, __ATOMIC_RELAXED, __HIP_MEMORY_SCOPE_AGENT)) < need) { __builtin_amdgcn_s_sleep(2); if (++spins > (1u << 22)) break; }
            __builtin_amdgcn_fence(__ATOMIC_ACQUIRE, "agent");
        }
        unsigned keyA[64], keyB[64];
        typedef __attribute__((address_space(1))) unsigned gu32_t;
        gu32_t* rowA = (gu32_t*)((unsigned*)(ws + WS_SC) + (size_t)(r0 + qA) * 4096) + lane; gu32_t* rowB = rowA + 4096;
#pragma unroll
        for (int j = 0; j < 64; ++j) { keyA[j] = rowA[64 * j]; keyB[j] = rowB[64 * j]; }
#pragma unroll
        for (int j = 0; j < 64; ++j) { keyA[j] = (j < nj) ? ord_key(keyA[j]) : 0x007FFFFFu; keyB[j] = (j < nj) ? ord_key(keyB[j]) : 0x007FFFFFu; }
        unsigned prefixA = 0u, prefixB = 0u; bool doneA = false, doneB = false;
        for (int bit = 31; bit >= 0 && !(doneA && doneB); --bit) {
            const unsigned candA = prefixA | (1u << bit), candB = prefixB | (1u << bit), cA1 = candA - 1u, cB1 = candB - 1u; unsigned a4[4] = {0u, 0u, 0u, 0u}, b4[4] = {0u, 0u, 0u, 0u};
#pragma unroll
            for (int j = 0; j < 64; ++j) { a4[j & 3] += min(__builtin_elementwise_sub_sat(keyA[j], cA1), 1u); b4[j & 3] += min(__builtin_elementwise_sub_sat(keyB[j], cB1), 1u); }
            const int cntA = wave_sum_i_dpp((int)((a4[0] + a4[1]) + (a4[2] + a4[3]))), cntB = wave_sum_i_dpp((int)((b4[0] + b4[1]) + (b4[2] + b4[3])));
            if (!doneA) { if (cntA >= 256) prefixA = candA; if (cntA == 256) doneA = true; }
            if (!doneB) { if (cntB >= 256) prefixB = candB; if (cntB == 256) doneB = true; }
        }
        SEL_FINISH(keyA, prefixA, doneA, mywA);
        SEL_FINISH(keyB, prefixB, doneB, mywB);
    }
    SEL[(size_t)qA * 64 + lane] = mywA; SEL[(size_t)qB * 64 + lane] = mywB;
}
#undef SEL_FINISH

__device__ __forceinline__ void attn_unit(const Frame& F, int l, int samp, int b, int c, int g) {
    const Args A = load_args();
    int tid = F.tid, lane = F.lane; const int wave = F.wave; asm volatile("" : "+v"(tid), "+v"(lane));
    __attribute__((address_space(1))) unsigned char* wsl_ = (__attribute__((address_space(1))) unsigned char*)F.ws; asm volatile("" : "+s"(wsl_)); unsigned char* ws = (unsigned char*)wsl_;
    const int r0 = samp ? MP + b * 64 : b * SEQ + c * 64;
    const int L = samp ? SKS : 64 * (c + 1), ntiles = L >> 6;
    const bf16_t* Kb = samp ? (const bf16_t*)(ws + WS_KS) + (size_t)b * SKS * 256 + g * 128 : (const bf16_t*)(ws + WS_KP) + (size_t)b * SEQ * 256 + g * 128;
    const bf16_t* Vb = samp ? (const bf16_t*)(ws + WS_VS) + (size_t)b * SKS * 256 + g * 128 : (const bf16_t*)(ws + WS_VP) + (size_t)b * SEQ * 256 + g * 128;
    const int hh = wave >> 1, qb = wave & 1, rl = lane & 31, h = lane >> 5, qrow = 32 * qb + rl, head = 4 * g + hh;
    const u64* SELr = (const u64*)(ws + WS_SEL) + (size_t)(r0 + qrow) * 64;
    bf16x8 qf[8];
    { const bf16_t* Qp = (const bf16_t*)(ws + WS_Q) + (size_t)(r0 + qrow) * WL + head * 128 + 8 * h;
#pragma unroll
      for (int ks = 0; ks < 8; ++ks) qf[ks] = *(const bf16x8*)(Qp + 16 * ks); }
    LAS unsigned char* KT = F.lds;
    LAS unsigned char* VT = F.lds + 34816;
    f32x16 o[4];
#pragma unroll
    for (int d = 0; d < 4; ++d)
#pragma unroll
        for (int i = 0; i < 16; ++i) o[d][i] = 0.f;
    float mrun = -INFINITY, lsum = 0.f;
    const float* CKf = A.in[I_CK] + ((size_t)(l * DB + b) * PAST) * 256 + g * 128; const float* CVf = A.in[I_CV] + ((size_t)(l * DB + b) * PAST) * 256 + g * 128;
    u32x4 kr[4], vr[4]; u64 mwn = 0ull, mwc;
    const int vp = tid & 31, vch = tid >> 5;
#define ATT_F32(t) (samp && (t) < (PAST >> 6))
#define ATT_LOAD(t) do { if (ATT_F32(t)) { \
            _Pragma("unroll") for (int i = 0; i < 2; ++i) { const int cid = tid + 512 * i; const float* p_ = CKf + (size_t)(64 * (t) + (cid >> 4)) * 256 + (cid & 15) * 8; kr[2 * i] = *(const u32x4*)(p_); kr[2 * i + 1] = *(const u32x4*)(p_ + 4); } \
            { const float* p_ = CVf + (size_t)(64 * (t) + 2 * vp) * 256 + vch * 8; vr[0] = *(const u32x4*)(p_); vr[1] = *(const u32x4*)(p_ + 4); vr[2] = *(const u32x4*)(p_ + 256); vr[3] = *(const u32x4*)(p_ + 260); } \
        } else { \
            _Pragma("unroll") for (int i = 0; i < 2; ++i) { const int cid = tid + 512 * i; kr[i] = *(const u32x4*)(Kb + (size_t)(64 * (t) + (cid >> 4)) * 256 + (cid & 15) * 8); } \
            vr[0] = *(const u32x4*)(Vb + (size_t)(64 * (t) + 2 * vp) * 256 + vch * 8); vr[1] = *(const u32x4*)(Vb + (size_t)(64 * (t) + 2 * vp + 1) * 256 + vch * 8); } \
        mwn = SELr[(t)]; } while (0)
#define ATT_PK(x_, y_) (u32x4){pk2(__uint_as_float((x_)[0]), __uint_as_float((x_)[1])), pk2(__uint_as_float((x_)[2]), __uint_as_float((x_)[3])), pk2(__uint_as_float((y_)[0]), __uint_as_float((y_)[1])), pk2(__uint_as_float((y_)[2]), __uint_as_float((y_)[3]))}
#define ATT_WRITE(buf, t) do { u32x4 k0_, k1_, va_, vb_; \
        if (ATT_F32(t)) { k0_ = ATT_PK(kr[0], kr[1]); k1_ = ATT_PK(kr[2], kr[3]); va_ = ATT_PK(vr[0], vr[1]); vb_ = ATT_PK(vr[2], vr[3]); } else { k0_ = kr[0]; k1_ = kr[1]; va_ = vr[0]; vb_ = vr[1]; } \
        *(LAS u32x4*)(KT + (buf) * 17408 + (tid >> 4) * 272 + (tid & 15) * 16) = k0_; *(LAS u32x4*)(KT + (buf) * 17408 + ((tid + 512) >> 4) * 272 + (tid & 15) * 16) = k1_; \
        _Pragma("unroll") for (int i = 0; i < 4; ++i) { const unsigned a = va_[i], bb = vb_[i]; \
            *(LAS unsigned*)(VT + (buf) * 17408 + (8 * vch + 2 * i) * 136 + vp * 4) = (a & 0xffffu) | (bb << 16); \
            *(LAS unsigned*)(VT + (buf) * 17408 + (8 * vch + 2 * i + 1) * 136 + vp * 4) = (a >> 16) | (bb & 0xffff0000u); } } while (0)
#define ATT_PIN8(a_) asm volatile("" : "+v"((a_)[0]), "+v"((a_)[1]), "+v"((a_)[2]), "+v"((a_)[3]), "+v"((a_)[4]), "+v"((a_)[5]), "+v"((a_)[6]), "+v"((a_)[7]))
#define ATT_PIN4(a_) asm volatile("" : "+v"((a_)[0]), "+v"((a_)[1]), "+v"((a_)[2]), "+v"((a_)[3]))
#define ATT_RDV(dst_, g_) do { _Pragma("unroll") for (int d = 0; d < 4; ++d) { union { bf16x8 v; u32x2 w[2]; } vf_; \
            const LAS unsigned char* vrow = VT + buf_ * 17408 + (32 * d + rl) * 136 + (32 * ((g_) >> 1) + 16 * ((g_) & 1) + 4 * h) * 2; \
            vf_.w[0] = *(const LAS u32x2*)(vrow); vf_.w[1] = *(const LAS u32x2*)(vrow + 16); (dst_)[d] = vf_.v; } } while (0)
#define ATT_COMPUTE(buf, mw) do { \
        const int buf_ = (buf); \
        f32x16 s[2]; \
        _Pragma("unroll") \
        for (int kh = 0; kh < 2; ++kh) \
        _Pragma("unroll") \
            for (int i = 0; i < 16; ++i) s[kh][i] = 0.f; \
        { bf16x8 ka0[8], ka1[8]; \
          _Pragma("unroll") for (int ks = 0; ks < 8; ++ks) ka0[ks] = *(const LAS bf16x8*)(KT + buf_ * 17408 + (rl) * 272 + (16 * ks + 8 * h) * 2); \
          _Pragma("unroll") for (int ks = 0; ks < 8; ++ks) ka1[ks] = *(const LAS bf16x8*)(KT + buf_ * 17408 + (32 + rl) * 272 + (16 * ks + 8 * h) * 2); \
          ATT_PIN8(ka0); ATT_PIN8(ka1); \
          _Pragma("unroll") for (int ks = 0; ks < 8; ++ks) { s[0] = __builtin_amdgcn_mfma_f32_32x32x16_bf16(ka0[ks], qf[ks], s[0], 0, 0, 0); s[1] = __builtin_amdgcn_mfma_f32_32x32x16_bf16(ka1[ks], qf[ks], s[1], 0, 0, 0); } } \
        bf16x8 vfa[4], vfb[4]; \
        ATT_RDV(vfa, 0); \
        const u64 mws = mw >> (4 * h); \
        const unsigned mlo = (unsigned)mws, mhi = (unsigned)(mws >> 32); \
        float mx = -INFINITY; \
        _Pragma("unroll") \
        for (int kh = 0; kh < 2; ++kh) \
        _Pragma("unroll") \
            for (int i = 0; i < 16; ++i) { const unsigned wv = kh ? mhi : mlo; const bool ok = (wv >> ((i & 3) + 8 * (i >> 2))) & 1u; s[kh][i] = ok ? s[kh][i] : -INFINITY; mx = fmaxf(mx, s[kh][i]); } \
        mx = fmaxf(mx, shflx(mx, 32)); \
        const float mnew = fmaxf(mrun, mx), muse = (mnew == -INFINITY) ? 0.f : mnew; \
        const float alpha = __builtin_amdgcn_exp2f(mrun - muse); \
        mrun = mnew; \
        float psum = 0.f; \
        _Pragma("unroll") \
        for (int kh = 0; kh < 2; ++kh) \
        _Pragma("unroll") \
            for (int i = 0; i < 16; ++i) { s[kh][i] = __builtin_amdgcn_exp2f(s[kh][i] - muse); psum += s[kh][i]; } \
        lsum = lsum * alpha + psum; \
        _Pragma("unroll") \
        for (int d = 0; d < 4; ++d) \
        _Pragma("unroll") \
            for (int i = 0; i < 16; ++i) o[d][i] *= alpha; \
        _Pragma("unroll") \
        for (int g_ = 0; g_ < 4; ++g_) { const int kh = g_ >> 1, sp = g_ & 1; \
            union { bf16x8 v; unsigned w[4]; } pf; \
            _Pragma("unroll") \
            for (int j = 0; j < 4; ++j) pf.w[j] = pk2(s[kh][8 * sp + 2 * j], s[kh][8 * sp + 2 * j + 1]); \
            if ((g_ & 1) == 0) { ATT_RDV(vfb, g_ + 1); ATT_PIN4(vfa); \
                _Pragma("unroll") for (int d = 0; d < 4; ++d) o[d] = __builtin_amdgcn_mfma_f32_32x32x16_bf16(vfa[d], pf.v, o[d], 0, 0, 0); } \
            else { if (g_ + 1 < 4) ATT_RDV(vfa, g_ + 1); ATT_PIN4(vfb); \
                _Pragma("unroll") for (int d = 0; d < 4; ++d) o[d] = __builtin_amdgcn_mfma_f32_32x32x16_bf16(vfb[d], pf.v, o[d], 0, 0, 0); } \
        } \
    } while (0)
    ATT_LOAD(0);
    ATT_WRITE(0, 0); mwc = mwn;
    __syncthreads();
    for (int t = 0; t < ntiles; ++t) {
        const int buf = t & 1;
        if (t + 1 < ntiles) ATT_LOAD(t + 1);
        ATT_COMPUTE(buf, mwc);
        if (t + 1 < ntiles) ATT_WRITE(buf ^ 1, t + 1);
        mwc = mwn; asm volatile("" : "+v"(mwc));
        __syncthreads();
    }
#undef ATT_COMPUTE
#undef ATT_RDV
#undef ATT_PIN4
#undef ATT_PIN8
#undef ATT_LOAD
#undef ATT_WRITE
#undef ATT_PK
#undef ATT_F32
    const float ltot = lsum + shflx(lsum, 32), inv = 1.0f / ltot;
    unsigned char* YC = ws + WS_Y + (size_t)2 * M * WL + (size_t)(r0 + qrow) * WL + head * 128;
#pragma unroll
    for (int d = 0; d < 4; ++d)
#pragma unroll
        for (int ig = 0; ig < 4; ++ig) *(unsigned*)(YC + 32 * d + 8 * ig + 4 * h) = pk4_fp8((f32x4){o[d][4 * ig] * inv, o[d][4 * ig + 1] * inv, o[d][4 * ig + 2] * inv, o[d][4 * ig + 3] * inv});
}
template <bool YPH>
__device__ __forceinline__ void lru_pair(const Frame& F, int l, int samp, int b, int c, int n0) {
    const Args A = load_args();
    int tid = F.tid, lane = F.lane; const int wave = F.wave; asm volatile("" : "+v"(tid), "+v"(lane));
    __attribute__((address_space(1))) unsigned char* wsl_ = (__attribute__((address_space(1))) unsigned char*)F.ws; asm volatile("" : "+s"(wsl_)); unsigned char* ws = (unsigned char*)wsl_;
    const int r0 = samp ? MP + b * 64 : b * SEQ + c * 64;
    const int grp = wave >> 2, w4 = wave & 3, n = n0 + grp;
    LAS unsigned char* lb = F.lds + grp * 47616;
    LAS unsigned char* XCb = lb;
    LAS float* Rl = (LAS float*)(lb + 9216);
    LAS float* Il = (LAS float*)(lb + 25856);
    LAS float* CP = (LAS float*)(lb + 42496);
    const int ch = tid & 63, tq = (tid >> 6) & 3, cg = n * 64 + ch;
    const int gate = w4 >> 1, r16 = lane & 15, hq = lane >> 4;
    bf16x8 bw[4][2]; float bv[4];
    { const bf16_t* LW = (const bf16_t*)(ws + WS_LRUW) + (size_t)((l * 2 + gate) * 16 + n) * 4096; const float* bias = A.in[gate ? I_LBI : I_LBR] + l * WL + n * 64;
#pragma unroll
      for (int nt = 0; nt < 4; ++nt) { bv[nt] = bias[16 * nt + r16];
#pragma unroll
          for (int ks = 0; ks < 2; ++ks) bw[nt][ks] = *(const bf16x8*)(LW + (16 * nt + r16) * 64 + 32 * ks + 8 * hq); } }
    const float lam = A.in[I_LAM][l * WL + cg];
    float* CH = (float*)(ws + WS_CH);
    f32x2 ph[16]; unsigned short gzr[16]; float h0s = 0.f;
    if (YPH) {
        const bf16_t* GZ = (const bf16_t*)(ws + WS_GZ);
#pragma unroll
        for (int k = 0; k < 16; ++k) gzr[k] = GZ[(size_t)(r0 + 16 * tq + k) * WL + cg];
        if (!samp) {
#pragma unroll
            for (int k = 0; k < 16; ++k) { const int cc = 16 * w4 + k; ph[k] = (f32x2){1.f, 0.f}; if (cc < c) ph[k] = *(const f32x2*)(CH + ((size_t)(b * 64 + cc) * WL + n * 64 + lane) * 2); }
        } else h0s = A.in[I_SH][(size_t)(l * DB + b) * WL + n * 64 + lane];
    }
    float xc[16];
    {
        const bf16_t* ZA = (const bf16_t*)(ws + WS_ZA);
        float zl[19]; unsigned zraw[19];
#pragma unroll
        for (int k = 0; k < 19; ++k) { const int tt = 16 * tq - 3 + k; unsigned v;
            if (tt >= 0 || c > 0) v = (unsigned)ZA[(size_t)(r0 + tt) * WL + cg];
            else v = samp ? __float_as_uint(A.in[I_SLC][((size_t)(l * DB + b) * 3 + (3 + tt)) * WL + cg]) : 0u;
            zraw[k] = v; }
        float cw[4];
#pragma unroll
        for (int j = 0; j < 4; ++j) cw[j] = A.in[I_LCW][(size_t)(l * 4 + j) * WL + cg];
        const float cb = A.in[I_LCB][l * WL + cg];
        asm volatile("" : "+v"(zraw[0]), "+v"(zraw[1]), "+v"(zraw[2]), "+v"(zraw[3]), "+v"(zraw[4]), "+v"(zraw[5]), "+v"(zraw[6]), "+v"(zraw[7]), "+v"(zraw[8]), "+v"(zraw[9]),
                     "+v"(zraw[10]), "+v"(zraw[11]), "+v"(zraw[12]), "+v"(zraw[13]), "+v"(zraw[14]), "+v"(zraw[15]), "+v"(zraw[16]), "+v"(zraw[17]), "+v"(zraw[18]));
#pragma unroll
        for (int k = 0; k < 19; ++k) { const int tt = 16 * tq - 3 + k; zl[k] = (tt >= 0 || c > 0) ? bf2f(zraw[k]) : __uint_as_float(zraw[k]); }
#pragma unroll
        for (int k = 0; k < 16; ++k) { xc[k] = cb + cw[0] * zl[k] + cw[1] * zl[k + 1] + cw[2] * zl[k + 2] + cw[3] * zl[k + 3];
            *(LAS bf16_t*)(XCb + (16 * tq + k) * 144 + ch * 2) = (bf16_t)f2bf(xc[k]); }
    }
    __syncthreads();
    {
        LAS float* dst = gate ? Il : Rl;
#pragma unroll
        for (int mm = 0; mm < 2; ++mm) { const int mt = 2 * (w4 & 1) + mm;
            bf16x8 a[2];
#pragma unroll
            for (int ks = 0; ks < 2; ++ks) a[ks] = *(const LAS bf16x8*)(XCb + (16 * mt + r16) * 144 + (32 * ks + 8 * hq) * 2);
#pragma unroll
            for (int nt = 0; nt < 4; ++nt) { f32x4 acc = (f32x4){0.f, 0.f, 0.f, 0.f};
#pragma unroll
                for (int ks = 0; ks < 2; ++ks) acc = __builtin_amdgcn_mfma_f32_16x16x32_bf16(a[ks], bw[nt][ks], acc, 0, 0, 0);
#pragma unroll
                for (int rg = 0; rg < 4; ++rg) dst[(16 * mt + 4 * hq + rg) * 65 + 16 * nt + r16] = sigmoidf_(acc[rg] + bv[nt]); } }
    }
    __syncthreads();
    float av[16], uv[16];
    {
        const float sp = log1pf(__expf(-lam));
        float rr_[16], ig_[16];
#pragma unroll
        for (int k = 0; k < 16; ++k) { const int t = 16 * tq + k; rr_[k] = Rl[t * 65 + ch]; ig_[k] = Il[t * 65 + ch]; }
        asm volatile("" : "+v"(rr_[0]), "+v"(rr_[1]), "+v"(rr_[2]), "+v"(rr_[3]), "+v"(rr_[4]), "+v"(rr_[5]), "+v"(rr_[6]), "+v"(rr_[7]), "+v"(rr_[8]), "+v"(rr_[9]), "+v"(rr_[10]), "+v"(rr_[11]), "+v"(rr_[12]), "+v"(rr_[13]), "+v"(rr_[14]), "+v"(rr_[15]) :: "memory");
        asm volatile("" : "+v"(ig_[0]), "+v"(ig_[1]), "+v"(ig_[2]), "+v"(ig_[3]), "+v"(ig_[4]), "+v"(ig_[5]), "+v"(ig_[6]), "+v"(ig_[7]), "+v"(ig_[8]), "+v"(ig_[9]), "+v"(ig_[10]), "+v"(ig_[11]), "+v"(ig_[12]), "+v"(ig_[13]), "+v"(ig_[14]), "+v"(ig_[15]) :: "memory");
#pragma unroll
        for (int k = 0; k < 16; ++k) { const float la = -8.0f * rr_[k] * sp; av[k] = __expf(la); uv[k] = sqrtf(fmaxf(1.0f - av[k] * av[k], 0.f)) * ig_[k] * xc[k]; }
    }
    if (YPH && !samp) {
        float P = 1.f, H = 0.f;
#pragma unroll
        for (int k = 0; k < 16; ++k) { H = ph[k].x * H + ph[k].y; P = P * ph[k].x; }
        CP[(w4 * 64 + lane) * 2] = P; CP[(w4 * 64 + lane) * 2 + 1] = H;
    }
    {
        LAS float* CP2 = (LAS float*)(lb + 44544);
        const int cgl = n * 64 + lane;
        float Pw = 1.f, Hw = 0.f;
#pragma unroll
        for (int k = 0; k < 16; ++k) { Hw = av[k] * Hw + uv[k]; Pw *= av[k]; }
        CP2[(w4 * 64 + lane) * 2] = Pw; CP2[(w4 * 64 + lane) * 2 + 1] = Hw;
        __syncthreads();
        float hst = 0.f;
        if (YPH) { if (samp) hst = h0s; else {
#pragma unroll
            for (int w = 0; w < 4; ++w) hst = CP[(w * 64 + lane) * 2] * hst + CP[(w * 64 + lane) * 2 + 1]; } }
        if (!YPH) {
            if (w4 == 0) { float P = 1.f;
#pragma unroll
                for (int w = 0; w < 4; ++w) { hst = CP2[(w * 64 + lane) * 2] * hst + CP2[(w * 64 + lane) * 2 + 1]; P *= CP2[(w * 64 + lane) * 2]; }
                *(f32x2*)(CH + ((size_t)(b * 64 + c) * WL + cgl) * 2) = (f32x2){P, hst}; }
        } else {
#pragma unroll
            for (int w = 0; w < 3; ++w) if (w < w4) hst = CP2[(w * 64 + lane) * 2] * hst + CP2[(w * 64 + lane) * 2 + 1];
            unsigned char* YA = ws + WS_Y;
#pragma unroll
            for (int k = 0; k < 16; ++k) { const int t = 16 * tq + k; hst = av[k] * hst + uv[k];
                const float yv = hst * bf2f(gzr[k]); YA[(size_t)(r0 + t) * WL + cg] = (unsigned char)(__builtin_amdgcn_cvt_pk_fp8_f32(yv, yv, 0, false) & 0xff); }
            if (w4 == 3) { if (samp) A.out[O_HS + (size_t)(l * DB + b) * WL + cgl] = hst; else if (c == 63) A.out[O_HP + (size_t)(l * 2 + b) * WL + cgl] = hst; }
        }
    }
    __syncthreads();
}

__device__ __forceinline__ void conf_unit(const Frame& F, int l, int unit) {
    const Args A = load_args();
    int tid = F.tid, lane = F.lane; const int wave = F.wave; asm volatile("" : "+v"(tid), "+v"(lane));
    __attribute__((address_space(1))) unsigned char* wsl_ = (__attribute__((address_space(1))) unsigned char*)F.ws; asm volatile("" : "+s"(wsl_)); unsigned char* ws = (unsigned char*)wsl_;
    const int r0 = unit * 32; const RowI ri = rowinfo(r0); const bool samp = r0 >= MP; const int t0 = ri.t;
    int tid2 = 2 * tid; asm volatile("" : "+v"(tid2));
    const bf16_t* GLU = (const bf16_t*)(ws + WS_GLU);
    const float* cwp = A.in[I_CCW] + (size_t)l * 31 * WL + tid2;
    f32x2 w[31];
#pragma unroll
    for (int j = 0; j < 31; ++j) w[j] = *(const f32x2*)(cwp + (size_t)j * WL);
    const f32x2 bias = *(const f32x2*)(A.in[I_CCB] + l * WL + tid2);
    f32x2 acc[32];
#pragma unroll
    for (int t = 0; t < 32; ++t) acc[t] = bias;
#pragma unroll
    for (int sg = 0; sg < 64; sg += 16) {
        f32x2 xg[16];
#pragma unroll
        for (int k = 0; k < 16; ++k) { const int s = sg + k; if (s < 62) {
            const int tg = t0 - 30 + s; f32x2 x;
            if (tg >= 0) { const unsigned u = *(const unsigned*)(GLU + (size_t)(r0 - 30 + s) * WL + tid2); x = (f32x2){bflo(u), bfhi(u)}; }
            else if (samp) x = *(const f32x2*)(A.in[I_SCC] + ((size_t)(l * DB + ri.b) * 30 + (30 + tg)) * WL + tid2);
            else x = (f32x2){0.f, 0.f};
            xg[k] = x; } }
#pragma unroll
        for (int k = 0; k < 16; ++k) { const int s = sg + k; if (s < 62) {
#pragma unroll
            for (int j = 0; j < 31; ++j) { const int t = s - j; if (t >= 0 && t < 32) acc[t] += w[j] * xg[k]; } } }
        asm volatile("" ::: "memory");
    }
    LAS float* CB = (LAS float*)F.lds;
#pragma unroll
    for (int t = 0; t < 32; ++t) *(LAS f32x2*)(CB + t * 1024 + tid2) = acc[t];
    __syncthreads();
    const float* lg = A.in[I_CLG] + l * WL; const float* lb = A.in[I_CLB] + l * WL; unsigned char* YB = ws + WS_Y + (size_t)M * WL;
    f32x4 lgv[4], lbv[4];
#pragma unroll
    for (int j = 0; j < 4; ++j) { lgv[j] = *(const f32x4*)(lg + 256 * j + 4 * lane); lbv[j] = *(const f32x4*)(lb + 256 * j + 4 * lane); }
#pragma unroll
    for (int k = 0; k < 4; ++k) { const int t = 4 * wave + k; f32x4 v[4]; float s = 0.f;
#pragma unroll
        for (int j = 0; j < 4; ++j) { v[j] = *(const LAS f32x4*)(CB + t * 1024 + 256 * j + 4 * lane); s += (v[j][0] + v[j][1]) + (v[j][2] + v[j][3]); }
        const float mean = wave_sum(s) * (1.0f / 1024.0f); float q = 0.f;
#pragma unroll
        for (int j = 0; j < 4; ++j) { v[j] = v[j] - mean; q += (v[j][0] * v[j][0] + v[j][1] * v[j][1]) + (v[j][2] * v[j][2] + v[j][3] * v[j][3]); }
        const float rstd = 1.0f / sqrtf(wave_sum(q) * (1.0f / 1024.0f) + LN_EPS);
#pragma unroll
        for (int j = 0; j < 4; ++j) { const int cix = 256 * j + 4 * lane; const f32x4 gg = lgv[j], bb = lbv[j]; f32x4 y = v[j] * rstd * gg + bb;
#pragma unroll
            for (int e = 0; e < 4; ++e) y[e] = y[e] * sigmoidf_(y[e]);
            *(unsigned*)(YB + (size_t)(r0 + t) * WL + cix) = pk4_fp8(y); } }
    __syncthreads();
}

template <int W>
__device__ __forceinline__ void pool_rows(const bf16_t* ZP, bf16_t* DF, const float* st, int r0, int t0, bool samp, int tid) {
    f32x2 x[64 + W - 1];
#pragma unroll
    for (int k = 0; k < 64 + W - 1; ++k) { const int rel = k - (W - 1), tg = t0 + rel;
        if (tg >= 0) { const unsigned u = *(const unsigned*)(ZP + (size_t)(r0 + rel) * WL + 2 * tid); x[k] = (f32x2){bflo(u), bfhi(u)}; }
        else if (samp) x[k] = *(const f32x2*)(st + (size_t)(15 + tg) * WL);
        else x[k] = (f32x2){0.f, 0.f}; }
    f32x2 rs = (f32x2){0.f, 0.f};
#pragma unroll
    for (int k = 0; k < W - 1; ++k) rs += x[k];
#pragma unroll
    for (int t = 0; t < 64; ++t) { rs += x[t + W - 1]; const f32x2 df = rs * (1.0f / W) - x[t + W - 1];
        *(unsigned*)(DF + (size_t)(r0 + t) * WL + 2 * tid) = pk2(df[0], df[1]);
        rs -= x[t]; }
}
__device__ __forceinline__ void pool_unit(const Frame& F, int l, int unit) {
    const Args A = load_args();
    int tid = F.tid; asm volatile("" : "+v"(tid));
    __attribute__((address_space(1))) unsigned char* wsl_ = (__attribute__((address_space(1))) unsigned char*)F.ws; asm volatile("" : "+s"(wsl_)); unsigned char* ws = (unsigned char*)wsl_;
    const int r0 = unit * 64; const RowI ri = rowinfo(r0); const bool samp = r0 >= MP; const int t0 = ri.t;
    const bf16_t* ZP = (const bf16_t*)(ws + WS_ZP); bf16_t* DF = (bf16_t*)(ws + WS_DIFF);
    const float* st = A.in[I_SPL] + (size_t)(l * DB + ri.b) * 15 * WL + 2 * tid;
    const int grp = tid >> 7;
    if (grp == 0) pool_rows<2>(ZP, DF, st, r0, t0, samp, tid);
    else if (grp == 1) pool_rows<4>(ZP, DF, st, r0, t0, samp, tid);
    else if (grp == 2) pool_rows<8>(ZP, DF, st, r0, t0, samp, tid);
    else pool_rows<16>(ZP, DF, st, r0, t0, samp, tid);
}

__device__ __forceinline__ void peer_score_unit(const Frame& F, int l, int unit) {
    int tid = F.tid, lane = F.lane; const int wave = F.wave; asm volatile("" : "+v"(tid), "+v"(lane));
    __attribute__((address_space(1))) unsigned char* wsl_ = (__attribute__((address_space(1))) unsigned char*)F.ws; asm volatile("" : "+s"(wsl_)); unsigned char* ws = (unsigned char*)wsl_;
    const int tt = unit >> 3, hd = unit & 7, r0 = tt * 64;
    LAS float* S = (LAS float*)F.lds;
    LAS float* SV = (LAS float*)(F.lds + 66048);
    LAS int* SI = (LAS int*)(F.lds + 66048 + 8192);
#ifndef P9_REP_A
#define P9_REP_A 1
#endif
#ifndef P9_REP_B
#define P9_REP_B 1
#endif
#ifndef P9_REP_C
#define P9_REP_C 1
#endif
    for (int repa = 0; repa < P9_REP_A; ++repa) {
        const int cc = wave >> 2, nb = wave & 3, rl = lane & 31, h = lane >> 5;
        const bf16_t* SK = (const bf16_t*)(ws + WS_SK) + ((size_t)((l * 8 + hd) * 2 + cc) * 128 + 32 * nb + rl) * 128 + 8 * h;
        bf16x8 bfr[8];
#pragma unroll
        for (int ks = 0; ks < 8; ++ks) bfr[ks] = *(const bf16x8*)(SK + 16 * ks);
        bf16x8 afr[2][8];
#pragma unroll
        for (int tb = 0; tb < 2; ++tb) { const bf16_t* QP = (const bf16_t*)(ws + WS_QP) + (size_t)(r0 + 32 * tb + rl) * D + hd * 256 + cc * 128 + 8 * h;
#pragma unroll
            for (int ks = 0; ks < 8; ++ks) afr[tb][ks] = *(const bf16x8*)(QP + 16 * ks); }
        asm volatile("" : "+v"(afr[0][0]), "+v"(afr[0][1]), "+v"(afr[0][2]), "+v"(afr[0][3]), "+v"(afr[0][4]), "+v"(afr[0][5]), "+v"(afr[0][6]), "+v"(afr[0][7]),
                     "+v"(afr[1][0]), "+v"(afr[1][1]), "+v"(afr[1][2]), "+v"(afr[1][3]), "+v"(afr[1][4]), "+v"(afr[1][5]), "+v"(afr[1][6]), "+v"(afr[1][7]));
#pragma unroll
        for (int tb = 0; tb < 2; ++tb) {
            f32x16 acc;
#pragma unroll
            for (int i = 0; i < 16; ++i) acc[i] = 0.f;
#pragma unroll
            for (int ks = 0; ks < 8; ++ks) acc = __builtin_amdgcn_mfma_f32_32x32x16_bf16(afr[tb][ks], bfr[ks], acc, 0, 0, 0);
#pragma unroll
            for (int i = 0; i < 16; ++i) { const int t = 32 * tb + (i & 3) + 8 * (i >> 2) + 4 * h; S[(cc * 64 + t) * 129 + 32 * nb + rl] = acc[i]; }
        }
    }
    __syncthreads();
    for (int repb = 0; repb < P9_REP_B; ++repb) {
        const int row = tid >> 2, qd = tid & 3;
        const LAS float* base = S + row * 129 + 32 * qd;
        unsigned x[32];
#pragma unroll
        for (int j = 0; j < 32; ++j) { const unsigned u = __float_as_uint(base[j]); const unsigned o = (u & 0x80000000u) ? ~u : (u | 0x80000000u); x[j] = (o & ~127u) | (unsigned)(127 - (32 * qd + j)); }
#define CE_DESC(a_, b_) do { const unsigned hi_ = max(x[a_], x[b_]), lo_ = min(x[a_], x[b_]); x[a_] = hi_; x[b_] = lo_; } while (0)
#pragma unroll
        for (int k = 2; k <= 16; k <<= 1)
#pragma unroll
            for (int j = k >> 1; j > 0; j >>= 1)
#pragma unroll
                for (int i = 0; i < 32; ++i) { const int l2 = i ^ j; if (l2 > i) { if ((i & k) == 0) CE_DESC(i, l2); else CE_DESC(l2, i); } }
#pragma unroll
        for (int i = 0; i < 16; ++i) x[i] = max(x[i], x[i + 16]);
#pragma unroll
        for (int j = 8; j > 0; j >>= 1)
#pragma unroll
            for (int i = 0; i < 16; ++i) { const int l2 = i ^ j; if (l2 > i) CE_DESC(i, l2); }
#define MERGE_LEVEL(ctrl_) do { \
            _Pragma("unroll") for (int i = 0; i < 16; ++i) x[16 + i] = (unsigned)__builtin_amdgcn_update_dpp(0, (int)x[i], ctrl_, 0xF, 0xF, false); \
            _Pragma("unroll") for (int i = 0; i < 16; ++i) x[i] = max(x[i], x[31 - i]); \
            _Pragma("unroll") for (int j = 8; j > 0; j >>= 1) _Pragma("unroll") for (int i = 0; i < 16; ++i) { const int l2 = i ^ j; if (l2 > i) CE_DESC(i, l2); } } while (0)
        MERGE_LEVEL(0xB1);
        MERGE_LEVEL(0x4E);
#undef MERGE_LEVEL
#undef CE_DESC
        if (qd == 0) {
#pragma unroll
            for (int k = 0; k < 16; ++k) { const int n = 127 - (int)(x[k] & 127u); SI[row * 16 + k] = n; SV[row * 16 + k] = S[row * 129 + n]; }
        }
    }
    __syncthreads();
    for (int repc = 0; repc < P9_REP_C; ++repc) if (tid < 64) {
        float a[16], c[16]; int p[16];
        const LAS float* bl = SV + (64 + tid) * 16;
        const float b0v = bl[0];
#pragma unroll
        for (int i = 0; i < 16; ++i) { a[i] = SV[tid * 16 + i]; c[i] = a[i] + b0v; p[i] = 0; }
        float fv[16]; int fi[16];
#pragma unroll
        for (int k = 0; k < 16; ++k) {
            float best = c[0]; int bi = 0;
#pragma unroll
            for (int i = 1; i < 16; ++i) if (c[i] > best) { best = c[i]; bi = i; }
            int pj = 0, lim = 16;
#pragma unroll
            for (int i = 0; i < 16; ++i) { pj = (i == bi) ? p[i] : pj; lim = (i == bi) ? 16 / (i + 1) : lim; }
            fv[k] = best; fi[k] = bi * 16 + pj;
            const int np = pj + 1; const float nb = bl[np & 15];
#pragma unroll
            for (int i = 0; i < 16; ++i) if (i == bi) { p[i] = np; c[i] = (np < lim) ? a[i] + nb : -INFINITY; }
        }
        float sum = 0.f;
        const float fmx = fv[0];
#pragma unroll
        for (int k = 0; k < 16; ++k) { fv[k] = __expf(fv[k] - fmx); sum += fv[k]; }
        const float inv = 1.0f / sum;
        int* EID = (int*)(ws + WS_EID) + (size_t)(r0 + tid) * 128 + hd * 16; float* GW = (float*)(ws + WS_GW) + (size_t)(r0 + tid) * 128 + hd * 16;
#pragma unroll
        for (int k = 0; k < 16; ++k) { const int i1 = SI[tid * 16 + (fi[k] >> 4)], i2 = SI[(64 + tid) * 16 + (fi[k] & 15)]; EID[k] = i1 * 128 + i2; GW[k] = fv[k] * inv; }
    }
    __syncthreads();
}

__device__ __forceinline__ void peer_gather(const Frame& F, int l) {
    const Args A = load_args();
    int lane = F.lane; asm volatile("" : "+v"(lane));
    __attribute__((address_space(1))) unsigned char* wsl_ = (__attribute__((address_space(1))) unsigned char*)F.ws; asm volatile("" : "+s"(wsl_)); unsigned char* ws = (unsigned char*)wsl_;
    const unsigned char* Ub = ws + WS_U + (size_t)l * NEXP * 1024; const unsigned char* Ue = ws + WS_U + (size_t)2 * NEXP * 1024 + (size_t)l * NEXP * 64;
    const unsigned char* Vb = ws + WS_V + (size_t)l * NEXP * 1024; const unsigned char* Ve = ws + WS_V4S + (size_t)l * NEXP * 64;
    bf16_t* XBp = (bf16_t*)(ws + WS_XB);
    const float* g2 = A.in[I_LN2G] + l * D; const float* b2 = A.in[I_LN2B] + l * D;
    for (int t = F.bid * NWAVES + F.wave; t < M; t += F.G * NWAVES) {
        asm volatile("" : "+v"(lane));
        int e0 = ((const int*)(ws + WS_EID))[(size_t)t * 128 + lane], e1 = ((const int*)(ws + WS_EID))[(size_t)t * 128 + 64 + lane];
        const float w0 = ((const float*)(ws + WS_GW))[(size_t)t * 128 + lane], w1 = ((const float*)(ws + WS_GW))[(size_t)t * 128 + 64 + lane];
        u32x4 xw4[4];
#pragma unroll
        for (int q = 0; q < 4; ++q) xw4[q] = *(const u32x4*)(XBp + (size_t)t * D + 32 * lane + 8 * q);
        asm volatile("" : "+v"(e0), "+v"(e1));
        f32x2 xp[16];
        f32x2 acc[16];
#pragma unroll
        for (int j = 0; j < 16; ++j) acc[j] = (f32x2){0.f, 0.f};
        u32x4 rr[16]; float rsc[16];
#define PG_EID(idx_) ((idx_) < 64 ? __builtin_amdgcn_readlane(e0, (idx_)) : __builtin_amdgcn_readlane(e1, (idx_) - 64))
#define PG_STEP(st_, eb_) do { const int g_ = (st_) >> 3, k_ = (st_) & 7; const int e_ = PG_EID((eb_) + 4 * g_ + (k_ & 3)); \
            if (k_ >= 4) { rr[st_] = *(const u32x4*)(Vb + (size_t)e_ * 1024 + 16 * lane); rsc[st_] = __uint_as_float((unsigned)Ve[(size_t)e_ * 64 + lane]); } \
            else { rr[st_] = *(const u32x4*)(Ub + (size_t)e_ * 1024 + 16 * lane); rsc[st_] = __uint_as_float((unsigned)Ue[(size_t)e_ * 64 + lane]); } } while (0)
#pragma unroll
        for (int s = 0; s < 15; ++s) PG_STEP(s, 0);
#pragma unroll
        for (int q = 0; q < 4; ++q) { const u32x4 w = xw4[q];
            xp[4 * q] = (f32x2){bflo(w.x), bfhi(w.x)}; xp[4 * q + 1] = (f32x2){bflo(w.y), bfhi(w.y)}; xp[4 * q + 2] = (f32x2){bflo(w.z), bfhi(w.z)}; xp[4 * q + 3] = (f32x2){bflo(w.w), bfhi(w.w)}; }
#pragma unroll 1
        for (int it = 0; it < 16; ++it) {
            const int eb = 8 * it;
            float cf[4];
#pragma unroll
            for (int s = 0; s < 16; ++s) {
                asm volatile("" ::: "memory");
                if (s == 0) PG_STEP(15, eb); else if (it < 15) PG_STEP(s - 1, eb + 8);
                asm volatile("" ::: "memory");
                const int g = s >> 3, k = s & 7;
                const float bsc = __uint_as_float(__float_as_uint(rsc[s]) << 23);
                if (k < 4) {
                    f32x2 d2 = (f32x2){0.f, 0.f};
#pragma unroll
                    for (int i = 0; i < 4; ++i) { const unsigned w = rr[s][i];
                        d2 += xp[4 * i + 0] * __builtin_amdgcn_cvt_scalef32_pk_f32_fp4(w, bsc, 0); d2 += xp[4 * i + 1] * __builtin_amdgcn_cvt_scalef32_pk_f32_fp4(w, bsc, 1);
                        d2 += xp[4 * i + 2] * __builtin_amdgcn_cvt_scalef32_pk_f32_fp4(w, bsc, 2); d2 += xp[4 * i + 3] * __builtin_amdgcn_cvt_scalef32_pk_f32_fp4(w, bsc, 3); }
                    const float act = wave_sum_dpp(d2[0] + d2[1]);
                    const int idx = eb + 4 * g + k;
                    const float gwt = __uint_as_float(idx < 64 ? __builtin_amdgcn_readlane(__float_as_uint(w0), idx) : __builtin_amdgcn_readlane(__float_as_uint(w1), idx - 64));
                    cf[k] = gwt * gelu_tanh(act);
                } else {
                    const float c1 = cf[k - 4];
#pragma unroll
                    for (int i = 0; i < 4; ++i) { const unsigned w = rr[s][i];
                        acc[4 * i + 0] += __builtin_amdgcn_cvt_scalef32_pk_f32_fp4(w, bsc, 0) * c1; acc[4 * i + 1] += __builtin_amdgcn_cvt_scalef32_pk_f32_fp4(w, bsc, 1) * c1;
                        acc[4 * i + 2] += __builtin_amdgcn_cvt_scalef32_pk_f32_fp4(w, bsc, 2) * c1; acc[4 * i + 3] += __builtin_amdgcn_cvt_scalef32_pk_f32_fp4(w, bsc, 3) * c1; }
                }
            }
        }
#undef PG_STEP
#undef PG_EID
        f32x4 g2v[8], b2v[8];
#pragma unroll
        for (int j = 0; j < 8; ++j) { g2v[j] = *(const f32x4*)(g2 + 32 * lane + 4 * j); b2v[j] = *(const f32x4*)(b2 + 32 * lane + 4 * j); }
        float s = 0.f;
#pragma unroll
        for (int j = 0; j < 16; ++j) { acc[j] = xp[j] * ALPHA + acc[j]; s += acc[j][0] + acc[j][1]; }
        const float mean = wave_sum(s) * (1.0f / D); float q2 = 0.f;
#pragma unroll
        for (int j = 0; j < 16; ++j) { acc[j] = acc[j] - mean; q2 += acc[j][0] * acc[j][0] + acc[j][1] * acc[j][1]; }
        const float rstd = 1.0f / sqrtf(wave_sum(q2) * (1.0f / D) + LN_EPS);
#pragma unroll
        for (int j = 0; j < 8; ++j) { const int cix = 32 * lane + 4 * j; const f32x4 gg = g2v[j], bb = b2v[j];
            const f32x4 av = (f32x4){acc[2 * j][0], acc[2 * j][1], acc[2 * j + 1][0], acc[2 * j + 1][1]};
            const f32x4 y = av * rstd * gg + bb;
            if (l == 1) *(f32x4*)(A.out + O_YP + (size_t)t * D + cix) = y; else { *(u32x2*)(XBp + (size_t)t * D + cix) = (u32x2){pk2(y[0], y[1]), pk2(y[2], y[3])}; *(unsigned*)(ws + WS_XB8 + (size_t)t * D + cix) = pk4_fp8(y); } }
    }
}
constexpr int NPHASES = 21;
template <unsigned MASK> __global__ void __launch_bounds__(NTHREADS, 2) fwd(Args A0) {
    extern __shared__ __attribute__((aligned(16))) unsigned char lds_raw[];
    Frame F0; F0.lds = (LAS unsigned char*)lds_raw; F0.ws = A0.ws; F0.ctl = (unsigned*)(A0.ws + WS_CTL);
    F0.tid = 0; F0.lane = 0; F0.wave = __builtin_amdgcn_readfirstlane((int)threadIdx.x >> 6); F0.G = gridDim.x; F0.bid = blockIdx.x;
    const Frame& F = F0;
#define PHASE_FRAME Frame F = F0; __attribute__((address_space(1))) unsigned char* w_ = (__attribute__((address_space(1))) unsigned char*)F0.ws; asm volatile("" : "+s"(w_), "+s"(F.bid), "+s"(F.G), "+s"(F.wave)); F.lane = fresh_lane(); F.tid = F.wave * 64 + F.lane; F.ws = (unsigned char*)w_; F.ctl = (unsigned*)(F.ws + WS_CTL); unsigned char* ws = F.ws; int l = l0_; asm volatile("" : "+s"(l))
    if (threadIdx.x < 64) ((LAS unsigned*)(F.lds + LDS_MISC))[threadIdx.x] = 0u;
    __syncthreads();
    const int lo = (MASK == 0x7ffu) ? 0 : A0.ph_lo, hi = (MASK == 0x7ffu) ? NPHASES : A0.ph_hi;
    const bool multi = (hi - lo) > 1;
    XcdBarrier bar; bar.bar = F.ctl + CW_BAR; bar.x = 0; bar.st = (volatile LAS unsigned*)(F.lds + LDS_MISC);
    if (multi) { bar = xcd_barrier_post(F.ctl + CW_BAR, (volatile LAS unsigned*)(F.lds + LDS_MISC)); xcd_barrier_census(bar); }
#define IN(k) (lo <= (k) && (k) < hi)
#define HAS(j) ((MASK >> (j)) & 1u)
#ifndef DUP_MASK
#define DUP_MASK 0u
#endif
#ifndef SUBDUP
#define SUBDUP 0u
#endif
#define SUBREP(b) (((SUBDUP >> (b)) & 1u) ? 2 : 1)
#define NREP(j) (((DUP_MASK >> (j)) & 1u) ? 2 : 1)
#define SEAM(k) do { if (IN(k) && IN((k) + 1)) xcd_barrier(bar); } while (0)

    if constexpr (HAS(0)) { if (IN(0)) { for (int rep = 0; rep < NREP(0); ++rep) { const int l0_ = 0; PHASE_FRAME; (void)l; p0_prologue(F); SEAM(0); } } }

    for (int l0_ = 0; l0_ < 2; ++l0_) {
        const int base = 1 + 10 * l0_;
        if constexpr (HAS(1)) if (IN(base + 0)) for (int rep = 0; rep < NREP(1); ++rep) {
            {
                PHASE_FRAME; (void)l;
                __syncthreads();
                pg8::Gemm g8{(const bf16_t*)(ws + WS_XB8), (const bf16_t*)(ws + WS_WIN8 + (size_t)l * 8192 * D), D / 2, D / 2, D / 2};
                pg8::StaticOrder S8; S8.init(M / 256, 32, F.G, F.bid, D / 2, D / 2);
                EpiGates E8{ws};
                pg8::gemm_phase<EpiGates, pg8::StaticOrder, true, true>(F.lds, g8, S8, E8, F.wave);
            }
            PHASE_FRAME; const int cwb = CW_ITEM + 64 * 8 * l + 1024 * rep; (void)cwb;
            __syncthreads();
            const Args A = load_args();
            EpiWin E{ws, A.out, l};
            pg8::Gemm g{(const bf16_t*)(ws + WS_XB), (const bf16_t*)(ws + WS_WIN) + (size_t)l * NPAD * D, D, D, D};
            pg8::StaticOrder S; S.init(M / 256, NT_BF, F.G, F.bid, D, D);
            pg8::gemm_phase<EpiWin, pg8::StaticOrder, true>(F.lds, g, S, E, F.wave);
            { const int nfull = (M / 256) * NT_BF - ((M / 256) * NT_BF / F.G) * F.G;
              if (nfull == 0 || F.bid >= nfull) { Frame Fv = F; if (nfull > 0) { Fv.bid = F.bid - nfull; Fv.G = F.G - nfull; } prep_b(Fv, l); } }
            SEAM(base + 0);
        }
        if constexpr (HAS(2)) if (IN(base + 1)) for (int rep = 0; rep < NREP(2); ++rep) {
            PHASE_FRAME; const int cwb = CW_ITEM + 64 * 8 * l + 1024 * rep; (void)cwb;
#ifndef NO_SEL
            for (int sr = 0; sr < SUBREP(0); ++sr) { for (int u = q_block(F, cwb + 0 + 2048 * sr); u < (1024 + 160); u = q_block(F, cwb + 0 + 2048 * sr)) {
                if (sr > 0) continue;
                if (u < 1024) { const int b = u >> 9, c = 63 - ((u >> 3) & 63), kc = u & 7; if (c >= 4 && kc < sel_nchunks(0, c)) score_item(F, l, 0, b, c, kc); }
                else { const int v = u - 1024; score_item(F, l, 1, v / 5, 0, v % 5); } } }
#endif
#ifndef NO_CONF
            for (int sr = 0; sr < SUBREP(1); ++sr) { for (int u = q_block(F, cwb + 64 + 2048 * sr); u < (M / 32); u = q_block(F, cwb + 64 + 2048 * sr)) { conf_unit(F, l, u); } }
#endif
#ifndef NO_POOL
            for (int sr = 0; sr < SUBREP(2); ++sr) { for (int u = q_block(F, cwb + 128 + 2048 * sr); u < (M / 64); u = q_block(F, cwb + 128 + 2048 * sr)) { pool_unit(F, l, u); } }
#endif
#ifndef NO_LRUX
            for (int sr = 0; sr < SUBREP(3); ++sr) { for (int u = q_block(F, cwb + 192 + 2048 * sr); u < (512); u = q_block(F, cwb + 192 + 2048 * sr)) { const int b = u >> 8, c = (u >> 2) & 63, nn = u & 3;
                lru_pair<false>(F, l, 0, b, c, 4 * nn); lru_pair<false>(F, l, 0, b, c, 4 * nn + 2); } }
#endif
#ifndef NO_SEL
            { for (int u = q_block(F, cwb + 448); u < (640); u = q_block(F, cwb + 448)) { const int uid = u >> 2, qg = u & 3;
                if (uid < 128) select_item(F, l, 0, uid >> 6, 63 - (uid & 63), qg); else select_item(F, l, 1, uid - 128, 0, qg); } }
#endif
            SEAM(base + 1);
        }
        if constexpr (HAS(3)) if (IN(base + 2)) for (int rep = 0; rep < NREP(3); ++rep) {
            PHASE_FRAME; const int cwb = CW_ITEM + 64 * 8 * l + 1024 * rep; (void)cwb;
            __syncthreads();
            {
                pg8::Gemm g{(const bf16_t*)(ws + WS_DIFF), (const bf16_t*)(ws + WS_POOLT) + (size_t)l * 4 * 256 * 256, WL, 256, 256};
                PoolOrder S{F.G, F.bid};
                const Args A = load_args();
                EpiPool E{ws + WS_Y + (size_t)3 * M * WL, A.in[I_PSC] + l * WL};
                for (int sr = 0; sr < SUBREP(6); ++sr) { __syncthreads(); pg8::gemm_phase<EpiPool, PoolOrder, true>(F.lds, g, S, E, F.wave); }
            }
#ifndef NO_ATT
            for (int sr = 0; sr < SUBREP(4); ++sr) { for (int u = q_block(F, cwb + 256 + 2048 * sr); u < (320); u = q_block(F, cwb + 256 + 2048 * sr)) {
                int samp, b, c, g;
                if (u < 124) { samp = 0; c = 63 - (u >> 2); b = (u >> 1) & 1; g = u & 1; } else if (u < 188) { const int v = u - 124; samp = 1; b = v >> 1; g = v & 1; c = 0; }
                else { const int v = u - 188; samp = 0; c = 32 - (v >> 2); b = (v >> 1) & 1; g = v & 1; }
                attn_unit(F, l, samp, b, c, g); } }
#endif
#ifndef NO_LRUY
            for (int sr = 0; sr < SUBREP(5); ++sr) { for (int u = q_block(F, cwb + 320 + 2048 * sr); u < (640); u = q_block(F, cwb + 320 + 2048 * sr)) {
                int samp, b, c, nn; if (u < 512) { samp = 0; b = u >> 8; c = (u >> 2) & 63; nn = u & 3; } else { const int v = u - 512; samp = 1; b = v >> 2; c = 0; nn = v & 3; }
                lru_pair<true>(F, l, samp, b, c, 4 * nn); lru_pair<true>(F, l, samp, b, c, 4 * nn + 2); } }
#endif
            SEAM(base + 2);
        }
        if constexpr (HAS(4)) if (IN(base + 3)) for (int rep = 0; rep < NREP(4); ++rep) {
            PHASE_FRAME; const int cwb = CW_ITEM + 64 * 8 * l + 1024 * rep; (void)cwb;
            __syncthreads();
            pg8::Gemm g{(const bf16_t*)(ws + WS_Y), (const bf16_t*)(ws + WS_WBR + (size_t)l * 4 * D * WL), WL / 2, WL / 2, WL / 2};
            BranchOrder S{F.G, F.bid};
            EpiGate E{(bf16_t*)(ws + WS_PG), ws + WS_GATES};
            pg8::gemm_phase<EpiGate, BranchOrder, true, true>(F.lds, g, S, E, F.wave);
            SEAM(base + 3);
        }
        if constexpr (HAS(5)) if (IN(base + 4)) for (int rep = 0; rep < NREP(5); ++rep) {
            PHASE_FRAME; const int cwb = CW_ITEM + 64 * 8 * l + 1024 * rep; (void)cwb;
            const bf16_t* PG = (const bf16_t*)(ws + WS_PG); bf16_t* Gm = (bf16_t*)(ws + WS_G);
            const size_t n8 = (size_t)M * D / 8, stride = (size_t)F.G * NTHREADS;
            for (size_t i = (size_t)F.bid * NTHREADS + F.tid; i < n8; i += stride) {
                f32x4 lo4 = (f32x4){0.f, 0.f, 0.f, 0.f}, hi4 = lo4;
#pragma unroll
                for (int z = 0; z < 4; ++z) { const u32x4 w = *(const u32x4*)(PG + (size_t)z * M * D + 8 * i);
                    lo4[0] += bflo(w.x); lo4[1] += bfhi(w.x); lo4[2] += bflo(w.y); lo4[3] += bfhi(w.y); hi4[0] += bflo(w.z); hi4[1] += bfhi(w.z); hi4[2] += bflo(w.w); hi4[3] += bfhi(w.w); }
                u32x4 o; o.x = pk2(lo4[0], lo4[1]); o.y = pk2(lo4[2], lo4[3]); o.z = pk2(hi4[0], hi4[1]); o.w = pk2(hi4[2], hi4[3]);
                *(u32x4*)(Gm + 8 * i) = o; }
            SEAM(base + 4);
        }
        if constexpr (HAS(6)) if (IN(base + 5)) for (int rep = 0; rep < NREP(6); ++rep) {
            PHASE_FRAME; const int cwb = CW_ITEM + 64 * 8 * l + 1024 * rep; (void)cwb;
            __syncthreads();
            pg8::Gemm g{(const bf16_t*)(ws + WS_G), (const bf16_t*)(ws + WS_WOUT) + (size_t)l * D * D, D, D, D};
            pg8::StaticOrder S; S.init(M / 256, D / 256, F.G, F.bid, D, D);
            const Args A = load_args();
            EpiOut E{A.in[I_XP], A.in[I_XS], (l == 0) ? (const bf16_t*)nullptr : (const bf16_t*)(ws + WS_XB), (bf16_t*)(ws + WS_PRE1)};
            pg8::gemm_phase<EpiOut, pg8::StaticOrder, true>(F.lds, g, S, E, F.wave);
            { const int nfull = (M / 256) * (D / 256) - ((M / 256) * (D / 256) / F.G) * F.G;
              if (nfull == 0 || F.bid >= nfull) { Frame Fv = F; if (nfull > 0) { Fv.bid = F.bid - nfull; Fv.G = F.G - nfull; } prep_u(Fv, l); if (l == 0) prep_a_bf(Fv, 1); } }
            SEAM(base + 5);
        }
        if constexpr (HAS(7)) if (IN(base + 6)) for (int rep = 0; rep < NREP(7); ++rep) {
            PHASE_FRAME; const int cwb = CW_ITEM + 64 * 8 * l + 1024 * rep; (void)cwb;
            const bf16_t* PRE = (const bf16_t*)(ws + WS_PRE1); bf16_t* XB = (bf16_t*)(ws + WS_XB);
            const Args A = load_args();
            const float* g1 = A.in[I_LN1G] + l * D; const float* b1 = A.in[I_LN1B] + l * D; const int lane = F.lane;
            f32x4 g1v[8], b1v[8];
#pragma unroll
            for (int j = 0; j < 4; ++j) { const int cix = 512 * j + 8 * lane; g1v[2 * j] = *(const f32x4*)(g1 + cix); g1v[2 * j + 1] = *(const f32x4*)(g1 + cix + 4); b1v[2 * j] = *(const f32x4*)(b1 + cix); b1v[2 * j + 1] = *(const f32x4*)(b1 + cix + 4); }
            for (int r = F.bid * NWAVES + F.wave; r < M; r += F.G * NWAVES) {
                f32x4 v[8]; float s = 0.f;
                u32x4 pw[4];
#pragma unroll
                for (int j = 0; j < 4; ++j) pw[j] = *(const u32x4*)(PRE + (size_t)r * D + 512 * j + 8 * lane);
                asm volatile("" : "+v"(pw[0]), "+v"(pw[1]), "+v"(pw[2]), "+v"(pw[3]));
#pragma unroll
                for (int j = 0; j < 4; ++j) { const u32x4 w = pw[j];
                    v[2 * j] = (f32x4){bflo(w.x), bfhi(w.x), bflo(w.y), bfhi(w.y)}; v[2 * j + 1] = (f32x4){bflo(w.z), bfhi(w.z), bflo(w.w), bfhi(w.w)};
                    s += ((v[2 * j][0] + v[2 * j][1]) + (v[2 * j][2] + v[2 * j][3])) + ((v[2 * j + 1][0] + v[2 * j + 1][1]) + (v[2 * j + 1][2] + v[2 * j + 1][3])); }
                const float mean = wave_sum(s) * (1.0f / D); float q = 0.f;
#pragma unroll
                for (int j = 0; j < 8; ++j) { v[j] = v[j] - mean; q += (v[j][0] * v[j][0] + v[j][1] * v[j][1]) + (v[j][2] * v[j][2] + v[j][3] * v[j][3]); }
                const float rstd = 1.0f / sqrtf(wave_sum(q) * (1.0f / D) + LN_EPS);
#pragma unroll
                for (int j = 0; j < 4; ++j) { const int cix = 512 * j + 8 * lane;
                    const f32x4 y0 = v[2 * j] * rstd * g1v[2 * j] + b1v[2 * j], y1 = v[2 * j + 1] * rstd * g1v[2 * j + 1] + b1v[2 * j + 1];
                    *(u32x4*)(XB + (size_t)r * D + cix) = (u32x4){pk2(y0[0], y0[1]), pk2(y0[2], y0[3]), pk2(y1[0], y1[1]), pk2(y1[2], y1[3])}; }
            }
            SEAM(base + 6);
        }
        if constexpr (HAS(8)) if (IN(base + 7)) for (int rep = 0; rep < NREP(8); ++rep) {
            PHASE_FRAME; const int cwb = CW_ITEM + 64 * 8 * l + 1024 * rep; (void)cwb;
            __syncthreads();
            pg8::Gemm g{(const bf16_t*)(ws + WS_XB), (const bf16_t*)(ws + WS_WQ) + (size_t)l * D * D, D, D, D};
            pg8::StaticOrder S; S.init(M / 256, D / 256, F.G, F.bid, D, D);
            EpiQ E{(bf16_t*)(ws + WS_QP)};
            pg8::gemm_phase<EpiQ, pg8::StaticOrder, true>(F.lds, g, S, E, F.wave);
            { const int nfull = (M / 256) * (D / 256) - ((M / 256) * (D / 256) / F.G) * F.G;
              if (nfull == 0 || F.bid >= nfull) { Frame Fv = F; if (nfull > 0) { Fv.bid = F.bid - nfull; Fv.G = F.G - nfull; } prep_c(Fv, l); if (l == 0) prep_a_f8(Fv, 1); } }
            SEAM(base + 7);
        }
        if constexpr (HAS(9)) if (IN(base + 8)) for (int rep = 0; rep < NREP(9); ++rep) {
            PHASE_FRAME; const int cwb = CW_ITEM + 64 * 8 * l + 1024 * rep; (void)cwb;
            { for (int u = q_block(F, cwb + 384); u < ((M / 64) * 8); u = q_block(F, cwb + 384)) { peer_score_unit(F, l, u); } }
            SEAM(base + 8);
        }
        if constexpr (HAS(10)) if (IN(base + 9)) for (int rep = 0; rep < ((l0_ == 1) ? NREP(10) : 1); ++rep) {
            PHASE_FRAME; const int cwb = CW_ITEM + 64 * 8 * l + 1024 * rep; (void)cwb;
            peer_gather(F, l);
            SEAM(base + 9);
        }
    }
#undef IN
#undef SEAM
#undef HAS
#undef NREP
#undef PHASE_FRAME
}

#ifndef N_SPLIT
#define N_SPLIT 1
#endif
template <unsigned MASK> static bool setup_kernel() { return hipFuncSetAttribute((const void*)fwd<MASK>, hipFuncAttributeMaxDynamicSharedMemorySize, LDS_BYTES) == hipSuccess; }
template <unsigned MASK> static void launch_kernel(int grid, hipStream_t stream, const Args& a) { hipLaunchKernelGGL(fwd<MASK>, dim3(grid), dim3(NTHREADS), LDS_BYTES, stream, a); }
extern "C" void kernel_launch(void* const* d_in, const int* in_sizes, int n_in, void* d_out, int out_size, void* d_ws, size_t ws_size, hipStream_t stream) {
    static int grid = 0;
    if (grid == 0) {
        if (n_in != 33 || (size_t)out_size != O_END || ws_size < WS_END) { fprintf(stderr, "kernel_launch: unexpected shapes (n_in %d out %d ws %zu need %zu)\n", n_in, out_size, ws_size, (size_t)WS_END); grid = -1; return; }
        int dev = 0, cus = 0;
        if (hipGetDevice(&dev) != hipSuccess || hipDeviceGetAttribute(&cus, hipDeviceAttributeMultiprocessorCount, dev) != hipSuccess) { grid = -1; return; }
        bool ok = true;
#if N_SPLIT == 1
        ok = setup_kernel<0x7ffu>();
#else
        ok = setup_kernel<1u>() && setup_kernel<2u>() && setup_kernel<4u>() && setup_kernel<8u>() && setup_kernel<16u>() && setup_kernel<32u>() && setup_kernel<64u>() && setup_kernel<128u>() && setup_kernel<256u>() && setup_kernel<512u>() && setup_kernel<1024u>();
#endif
        if (!ok) { fprintf(stderr, "kernel_launch: hipFuncSetAttribute failed\n"); grid = -1; return; }
        (void)hipGetLastError();
        grid = cus;
    }
    if (grid < 0) return;
    (void)hipMemsetAsync((char*)d_ws + WS_CTL, 0, CTL_BYTES, stream);
    Args a{};
    for (int i = 0; i < 33; ++i) a.in[i] = (const float*)d_in[i];
    a.out = (float*)d_out; a.ws = (unsigned char*)d_ws;
#if N_SPLIT == 1
    a.ph_lo = 0; a.ph_hi = NPHASES; launch_kernel<0x7ffu>(grid, stream, a);
#else
    for (int p = 0; p < NPHASES; ++p) { a.ph_lo = p; a.ph_hi = p + 1; const int j = (p == 0) ? 0 : 1 + (p - 1) % 10;
        switch (j) { case 0: launch_kernel<1u>(grid, stream, a); break; case 1: launch_kernel<2u>(grid, stream, a); break; case 2: launch_kernel<4u>(grid, stream, a); break; case 3: launch_kernel<8u>(grid, stream, a); break;
            case 4: launch_kernel<16u>(grid, stream, a); break; case 5: launch_kernel<32u>(grid, stream, a); break; case 6: launch_kernel<64u>(grid, stream, a); break; case 7: launch_kernel<128u>(grid, stream, a); break;
            case 8: launch_kernel<256u>(grid, stream, a); break; case 9: launch_kernel<512u>(grid, stream, a); break; default: launch_kernel<1024u>(grid, stream, a); break; } }
#endif
}
```

```cpp
#include <hip/hip_runtime.h>
#include <cstdio>
#include <cstdint>

#define LAS __attribute__((address_space(3)))
typedef unsigned short bf16_t;
typedef short bf16x8 __attribute__((ext_vector_type(8)));
typedef float f32x4 __attribute__((ext_vector_type(4)));
typedef float f32x2 __attribute__((ext_vector_type(2)));
typedef float f32x16 __attribute__((ext_vector_type(16)));
typedef unsigned u32x4 __attribute__((ext_vector_type(4)));
typedef unsigned u32x2 __attribute__((ext_vector_type(2)));
typedef unsigned long long u64;

constexpr int D = 2048, SEQ = 4096, MP = 2 * SEQ, DB = 32, DSQ = 64, MS = DB * DSQ, M = MP + MS, PAST = 2048, SKS = PAST + DSQ;
constexpr int NT_BF = 29;
constexpr int NPROJ = 15432, NPAD = 15616, NT_IN = NPAD / 256;
constexpr int WL = 1024;
constexpr int NEXP = 16384;
constexpr float ALPHA = 1.41421356237f;
constexpr float LN_EPS = 1e-5f;
constexpr float QSCALE = 0.08838834764831845f * 1.4426950408889634f;

constexpr size_t O_YP = 0, O_YS = O_YP + (size_t)MP * D, O_KP = O_YS + (size_t)MS * D, O_VP = O_KP + (size_t)2 * MP * 256, O_KIP = O_VP + (size_t)2 * MP * 256,
    O_HP = O_KIP + (size_t)2 * MP * 64, O_LCP = O_HP + 2 * 2 * 1024, O_CCP = O_LCP + 2 * 2 * 3 * 1024, O_PP = O_CCP + 2 * 2 * 30 * 1024, O_KS = O_PP + 2 * 2 * 15 * 1024,
    O_VS = O_KS + (size_t)2 * MS * 256, O_KIS = O_VS + (size_t)2 * MS * 256, O_HS = O_KIS + (size_t)2 * MS * 64, O_LCS = O_HS + 2 * 32 * 1024, O_CCS = O_LCS + 2 * 32 * 3 * 1024,
    O_PS = O_CCS + 2 * 32 * 30 * 1024, O_END = O_PS + 2 * 32 * 15 * 1024;
static_assert(O_END == 36179968, "output size");

constexpr size_t al256(size_t x) { return (x + 255) & ~(size_t)255; }
constexpr size_t WS_CTL = 0, CTL_BYTES = 1u << 20;
constexpr size_t WS_WIN = CTL_BYTES;
constexpr size_t WS_WBR = WS_WIN + (size_t)2 * NPAD * 2048 * 2;
constexpr size_t WS_WOUT = WS_WBR + (size_t)2 * 8192 * 1024 * 2;
constexpr size_t WS_WQ = WS_WOUT + (size_t)2 * 2048 * 2048 * 2;
constexpr size_t WS_POOLT = WS_WQ + (size_t)2 * 2048 * 2048 * 2;
constexpr size_t WS_LRUW = WS_POOLT + (size_t)2 * 1024 * 256 * 2;
constexpr size_t WS_SK = WS_LRUW + (size_t)2 * 2 * 16 * 64 * 64 * 2;
constexpr size_t WS_ROPE = WS_SK + (size_t)2 * 8 * 2 * 128 * 128 * 2;
constexpr size_t WS_U = WS_ROPE + (size_t)4096 * 48 * 4;
constexpr size_t WS_V = WS_U + (size_t)2 * NEXP * 2048 * 2;
constexpr size_t WS_XB = WS_V + (size_t)2 * NEXP * 2048 * 2;
constexpr size_t WS_XF = WS_XB + (size_t)M * D * 2;
constexpr size_t WS_ZA = WS_XF + (size_t)M * D * 4;
constexpr size_t WS_GZ = WS_ZA + (size_t)M * WL * 2;
constexpr size_t WS_GLU = WS_GZ + (size_t)M * WL * 2;
constexpr size_t WS_Q = WS_GLU + (size_t)M * WL * 2;
constexpr size_t WS_ZP = WS_Q + (size_t)M * WL * 2;
constexpr size_t WS_DIFF = WS_ZP + (size_t)M * WL * 2;
constexpr size_t WS_KP = WS_DIFF + (size_t)M * WL * 2;
constexpr size_t WS_VP = WS_KP + (size_t)MP * 256 * 2;
constexpr size_t WS_KS = WS_VP + (size_t)MP * 256 * 2;
constexpr size_t WS_VS = WS_KS + (size_t)DB * SKS * 256 * 2;
constexpr size_t WS_QI = WS_VS + (size_t)DB * SKS * 256 * 2;
constexpr size_t WS_KIP = WS_QI + (size_t)M * 512 * 2;
constexpr size_t WS_KIS = WS_KIP + (size_t)MP * 64 * 2;
constexpr size_t WS_WI = WS_KIS + (size_t)DB * SKS * 64 * 2;
constexpr size_t WS_GATES = WS_WI + (size_t)M * 8 * 4;
constexpr size_t WS_Y = WS_GATES + (size_t)M * 8192 * 2;
constexpr size_t WS_R1 = WS_Y + (size_t)4 * M * WL * 2;
constexpr size_t WS_SEL = WS_R1 + (size_t)M * 4096 * 4;
constexpr size_t WS_EID = WS_SEL + (size_t)M * 64 * 8;
constexpr size_t WS_GW = WS_EID + (size_t)M * 128 * 4;
constexpr size_t WS_CH = WS_GW + (size_t)M * 128 * 4;
constexpr size_t WS_USC = WS_CH + (size_t)2 * 64 * 1024 * 2 * 4;
constexpr size_t WS_VSC = WS_USC + (size_t)2 * NEXP * 4;
constexpr size_t WS_END = WS_VSC + (size_t)2 * NEXP * 4;
static_assert(WS_END < (size_t)1262 * 1024 * 1024, "workspace over budget");
constexpr size_t WS_WIN8 = WS_U + ((size_t)48 << 20);
constexpr size_t WS_XB8 = WS_U + ((size_t)96 << 20);
static_assert(WS_U + (size_t)2 * NEXP * 1024 + (size_t)2 * NEXP * 64 <= WS_WIN8 && WS_WIN8 + (size_t)2 * 8192 * 2048 <= WS_XB8 && WS_XB8 + (size_t)M * D <= WS_V, "fp8 operands overlap");
constexpr size_t WS_G = WS_Y, WS_SC = WS_R1, WS_PG = WS_R1, WS_PRE1 = WS_R1, WS_QP = WS_R1 + (size_t)M * D * 4;

constexpr int CW_BAR = 4096;
constexpr int LDS_BYTES = 147456;
constexpr int LDS_MISC = 131072 + 8192;
constexpr int NTHREADS = 512, NWAVES = 8;

__device__ __forceinline__ float bf2f(unsigned v) { return __uint_as_float(v << 16); }
__device__ __forceinline__ unsigned f2bf(float f) { unsigned u = __float_as_uint(f); return (u + 0x7fffu + ((u >> 16) & 1u)) >> 16; }
typedef __bf16 bf16x2n_t __attribute__((ext_vector_type(2)));
__device__ __forceinline__ unsigned pk2(float lo, float hi) { typedef float f2_ __attribute__((ext_vector_type(2))); const bf16x2n_t b = __builtin_convertvector((f2_){lo, hi}, bf16x2n_t); return __builtin_bit_cast(unsigned, b); }
__device__ __forceinline__ unsigned pk4_fp8(f32x4 v) { int w = 0; w = __builtin_amdgcn_cvt_pk_fp8_f32(v[0], v[1], w, false); w = __builtin_amdgcn_cvt_pk_fp8_f32(v[2], v[3], w, true); return (unsigned)w; }
__device__ __forceinline__ float bflo(unsigned w) { return __uint_as_float(w << 16); }
__device__ __forceinline__ float bfhi(unsigned w) { return __uint_as_float(w & 0xffff0000u); }
__device__ __forceinline__ float frcp(float x) { return __builtin_amdgcn_rcpf(x); }
__device__ __forceinline__ float sigmoidf_(float x) { return frcp(1.0f + __expf(-x)); }
__device__ __forceinline__ float sig255(float x) { return frcp(__builtin_fmaf(__expf(-x), 1.0f / 255.0f, 1.0f / 255.0f)); }
__device__ __forceinline__ unsigned pk4_u8(float a, float b, float c, float d) { unsigned w = 0u; w = __builtin_amdgcn_cvt_pk_u8_f32(a, 0, w); w = __builtin_amdgcn_cvt_pk_u8_f32(b, 1, w); w = __builtin_amdgcn_cvt_pk_u8_f32(c, 2, w); w = __builtin_amdgcn_cvt_pk_u8_f32(d, 3, w); return w; }
__device__ __forceinline__ float gate_u8(unsigned w, int k) { return __builtin_fmaf((float)((w >> (8 * k)) & 0xffu), 1.0f / 255.0f, 0.5f / 255.0f); }
__device__ __forceinline__ float gelu_tanh(float x) { const float u = 0.7978845608028654f * (x + 0.044715f * x * x * x); const float e = __expf(2.0f * u); return 0.5f * x * (2.0f - 2.0f * frcp(e + 1.0f)); }
__device__ __forceinline__ float sigmoid_ieee(float x) { return 1.0f / (1.0f + __expf(-x)); }
__device__ __forceinline__ float gelu_ieee(float x) { const float u = 0.7978845608028654f * (x + 0.044715f * x * x * x); const float e = __expf(2.0f * u); return 0.5f * x * (2.0f - 2.0f / (e + 1.0f)); }

__device__ __forceinline__ float wave_sum_dpp(float v) {
#define DPP_ADD(ctrl, rmask) v += __int_as_float(__builtin_amdgcn_update_dpp(0, __float_as_int(v), ctrl, rmask, 0xF, false))
    DPP_ADD(0xB1, 0xF);
    DPP_ADD(0x4E, 0xF);
    DPP_ADD(0x141, 0xF);
    DPP_ADD(0x140, 0xF);
    DPP_ADD(0x142, 0xA);
    DPP_ADD(0x143, 0xC);
#undef DPP_ADD
    return __int_as_float(__builtin_amdgcn_readlane(__float_as_int(v), 63));
}

__device__ __forceinline__ int fresh_lane() { int ln; asm volatile("v_mbcnt_lo_u32_b32 %0, -1, 0\n\tv_mbcnt_hi_u32_b32 %0, -1, %0" : "=v"(ln)); return ln; }
__device__ __forceinline__ float shflx(float v, int m) { const int ln = fresh_lane(); return __int_as_float(__builtin_amdgcn_ds_bpermute((ln ^ m) << 2, __float_as_int(v))); }
__device__ __forceinline__ int shflx_i(int v, int m) { const int ln = fresh_lane(); return __builtin_amdgcn_ds_bpermute((ln ^ m) << 2, v); }
__device__ __forceinline__ float wave_sum(float v) {
    const int ln = fresh_lane();
#pragma unroll
    for (int o = 1; o < 64; o <<= 1) v += __int_as_float(__builtin_amdgcn_ds_bpermute((ln ^ o) << 2, __float_as_int(v)));
    return v;
}

__device__ __forceinline__ float wave_max_dpp(float v) {
    const int ninf = (int)0xff800000u;
#define DPP_MAX(ctrl, rmask) v = fmaxf(v, __int_as_float(__builtin_amdgcn_update_dpp(ninf, __float_as_int(v), ctrl, rmask, 0xF, false)))
    DPP_MAX(0xB1, 0xF); DPP_MAX(0x4E, 0xF); DPP_MAX(0x141, 0xF); DPP_MAX(0x140, 0xF); DPP_MAX(0x142, 0xA); DPP_MAX(0x143, 0xC);
#undef DPP_MAX
    return __int_as_float(__builtin_amdgcn_readlane(__float_as_int(v), 63));
}
namespace pg8 {
#define PG8_LAS __attribute__((address_space(3)))
constexpr int BM = 256, BK = 64, HALF = 128, HTB = HALF * BK * 2  , STAGE_BYTES = 8 * HTB, NXCD = 8, WGM = 8;
__host__ __device__ __forceinline__ int lds_byte(int r, int c) { const int st = (r >> 4) * 2 + (c >> 5), rr = r & 15, cc = c & 31, ob = rr * 64 + cc * 2; return st * 1024 + (ob ^ (((ob >> 9) & 1) << 5)); }
__host__ __device__ __forceinline__ void stage_rc(int b, int& R, int& C) { const int st = b / 1024, sb = b % 1024, swz = sb ^ (((sb >> 9) & 1) << 5); R = (st >> 1) * 16 + swz / 64; C = (st & 1) * 32 + (swz % 64) / 2; }
__host__ __device__ __forceinline__ int perm32(int rho) { const int n = rho >> 4, i = rho & 15; return 8 * (i >> 2) + 4 * n + (i & 3); }

struct Unit { int pm, pn, z; size_t aoff, boff; };
struct Gemm { const bf16_t* A; const bf16_t* Bt; int lda, ldb, K; };

struct StaticOrder {
    int nM, nN, nwg, G, c, pn0; size_t astep, bstep;
    __device__ void init(int nM_, int nN_, int G_, int c_, int lda, int ldb) { nM = nM_; nN = nN_; nwg = nM * nN; G = G_; c = c_; pn0 = 0; astep = (size_t)256 * lda * 2; bstep = (size_t)256 * ldb * 2; }
    __device__ bool next(int i, Unit& u) const {
        const long L = (long)i * G + c; if (L >= nwg) return false;
        int wgid = (int)L; { const int q = nwg / NXCD, r = nwg % NXCD, xcd = wgid % NXCD, off = wgid / NXCD; wgid = (xcd < r ? xcd * (q + 1) : r * (q + 1) + (xcd - r) * q) + off; }
        const int nig = WGM * nN, gid = wgid / nig, fm = gid * WGM, gsz = (nM - fm) < WGM ? (nM - fm) : WGM;
        u.pm = fm + ((wgid % nig) % gsz); u.pn = (wgid % nig) / gsz; u.z = 0; u.aoff = (size_t)u.pm * astep; u.boff = (size_t)u.pn * bstep; u.pn += pn0; return true;
    }
};

__device__ __forceinline__ unsigned cvt_pk_bf16(float lo, float hi) { unsigned r; asm volatile("v_cvt_pk_bf16_f32 %0, %1, %2" : "=v"(r) : "v"(lo), "v"(hi)); return r; }

typedef int i32x8 __attribute__((ext_vector_type(8)));
__device__ __forceinline__ i32x8 cat8(bf16x8 lo, bf16x8 hi) { typedef int i32x4_ __attribute__((ext_vector_type(4))); const i32x4_ a = __builtin_bit_cast(i32x4_, lo), b = __builtin_bit_cast(i32x4_, hi); return __builtin_shufflevector(a, b, 0, 1, 2, 3, 4, 5, 6, 7); }
template <class Epi, class Sched, bool ALIGN_EPI, bool F8 = false>
__device__ __forceinline__ void gemm_phase(PG8_LAS unsigned char* lds, const Gemm g, const Sched& S, const Epi& E, const int wid) {
    const int lane = fresh_lane(), tid = wid * 64 + lane;
    const int wr = wid >> 2, wc = wid & 3, fr = lane & 15, fq = lane >> 4;
    int K = g.K; asm volatile("" : "+s"(K));
    const int nt = K / BK;
    unsigned voffA, voffB;
    { int R, C; stage_rc(tid * 16, R, C); const int Rb = Epi::PERM ? ((R & ~31) + perm32(R & 31)) : R; voffA = (unsigned)(R * g.lda + C) * 2u; voffB = (unsigned)(Rb * g.ldb + C) * 2u; }
    const unsigned voffA_d = 64u * (unsigned)g.lda * 2u, voffB_d = 64u * (unsigned)g.ldb * 2u;
    const size_t kstep = (size_t)(BK * 2);
    const size_t hA = (size_t)HALF * g.lda * 2, hB = (size_t)HALF * g.ldb * 2;
    const unsigned ldsw = (unsigned)wid * 1024u;
    const int aoff = lds_byte(wr * 64 + fr, fq * 8), boff = lds_byte(wc * 32 + fr, fq * 8);
#define PG8_SA(b, h) (((b) * 2 + (h)) * HTB)
#define PG8_SB(b, h) ((4 + (b) * 2 + (h)) * HTB)
#define PG8_STAGE(bufoff, gbase, voff) do { _Pragma("unroll") for (int _i = 0; _i < 2; ++_i) \
        { unsigned vo_ = (voff) + _i * voff##_d; asm volatile("" : "+v"(vo_)); __builtin_amdgcn_global_load_lds((const unsigned*)((const char*)(gbase) + vo_), (PG8_LAS unsigned*)(lds + (bufoff) + ldsw + _i * 8192), 16, 0, 0); } } while (0)
#define PG8_LDA(dst, b, h) do { _Pragma("unroll") for (int m = 0; m < 4; ++m) _Pragma("unroll") for (int k = 0; k < 2; ++k) dst[m][k] = *(const PG8_LAS bf16x8*)(lds + PG8_SA(b, h) + aoff + m * 2048 + k * 1024); } while (0)
#define PG8_LDB(dst, b, h) do { _Pragma("unroll") for (int n = 0; n < 2; ++n) _Pragma("unroll") for (int k = 0; k < 2; ++k) dst[n][k] = *(const PG8_LAS bf16x8*)(lds + PG8_SB(b, h) + boff + n * 2048 + k * 1024); } while (0)
#define PG8_MMA(ai, bj, At, Bt) do { __builtin_amdgcn_s_setprio(1); \
        if constexpr (F8) { _Pragma("unroll") for (int m = 0; m < 4; ++m) _Pragma("unroll") for (int n = 0; n < 2; ++n) \
            acc[ai][bj][m][n] = __builtin_amdgcn_mfma_scale_f32_16x16x128_f8f6f4(cat8(Bt[n][0], Bt[n][1]), cat8(At[m][0], At[m][1]), acc[ai][bj][m][n], 0, 0, 0, 0, 0, 0); } \
        else { _Pragma("unroll") for (int m = 0; m < 4; ++m) _Pragma("unroll") for (int n = 0; n < 2; ++n) _Pragma("unroll") for (int k = 0; k < 2; ++k) \
            acc[ai][bj][m][n] = __builtin_amdgcn_mfma_f32_16x16x32_bf16(Bt[n][k], At[m][k], acc[ai][bj][m][n], 0, 0, 0); } \
        __builtin_amdgcn_s_setprio(0); } while (0)
#define PG8_WAIT_V(n) asm volatile("s_waitcnt vmcnt(" #n ")" ::: "memory")
#define PG8_WAIT_L(n) asm volatile("s_waitcnt lgkmcnt(" #n ")" ::: "memory")
#define PG8_BAR __builtin_amdgcn_s_barrier()
#define PG8_SCHED __builtin_amdgcn_sched_barrier(0)
    Unit cur, nxt; int ui = 0;
    if (!S.next(0, cur)) return;
    f32x4 acc[2][2][4][2];
#pragma unroll
    for (int a = 0; a < 2; ++a)
#pragma unroll
        for (int b = 0; b < 2; ++b)
#pragma unroll
            for (int m = 0; m < 4; ++m)
#pragma unroll
                for (int n = 0; n < 2; ++n) acc[a][b][m][n] = (f32x4){0.f, 0.f, 0.f, 0.f};
    bf16x8 At[4][2], B0[2][2], B1[2][2];
    const char* cA = (const char*)g.A + cur.aoff; const char* cB = (const char*)g.Bt + cur.boff;
    PG8_STAGE(PG8_SB(0, 0), cB, voffB); PG8_STAGE(PG8_SB(0, 1), cB + hB, voffB); PG8_STAGE(PG8_SA(0, 0), cA, voffA); PG8_STAGE(PG8_SA(0, 1), cA + hA, voffA);
    if (wr == 1) PG8_BAR;
    PG8_WAIT_V(2); PG8_BAR;
    PG8_STAGE(PG8_SB(1, 0), cB + kstep, voffB); PG8_STAGE(PG8_SA(1, 0), cA + kstep, voffA); PG8_STAGE(PG8_SB(1, 1), cB + hB + kstep, voffB);
    PG8_WAIT_V(6); PG8_BAR;
    for (;;) {
        const bool has_next = S.next(ui + 1, nxt);
        const char* nA = has_next ? (const char*)g.A + nxt.aoff : cA; const char* nB = has_next ? (const char*)g.Bt + nxt.boff : cB;
        for (int t = 0; t < nt; t += 2) {
            const bool last = (t == nt - 2);
            const char* a1 = cA + (size_t)(t + 1) * kstep;
            const char* a2 = last ? nA : cA + (size_t)(t + 2) * kstep; const char* b2 = last ? nB : cB + (size_t)(t + 2) * kstep;
            const char* a3 = a2 + kstep; const char* b3 = b2 + kstep;
            PG8_LDB(B0, 0, 0); PG8_LDB(B1, 0, 1); PG8_SCHED; PG8_LDA(At, 0, 0); PG8_STAGE(PG8_SA(1, 1), a1 + hA, voffA);
            PG8_WAIT_V(8); PG8_WAIT_L(0); PG8_BAR; PG8_MMA(0, 0, At, B0); PG8_MMA(0, 1, At, B1); PG8_BAR; PG8_SCHED;
            PG8_LDA(At, 0, 1); PG8_STAGE(PG8_SB(0, 0), b2, voffB); PG8_STAGE(PG8_SB(0, 1), b2 + hB, voffB); PG8_STAGE(PG8_SA(0, 0), a2, voffA);
            PG8_WAIT_V(8); PG8_WAIT_L(0); PG8_BAR; PG8_MMA(1, 0, At, B0); PG8_MMA(1, 1, At, B1); PG8_BAR; PG8_SCHED;
            PG8_LDB(B0, 1, 0); PG8_LDB(B1, 1, 1); PG8_SCHED; PG8_LDA(At, 1, 0); PG8_STAGE(PG8_SA(0, 1), a2 + hA, voffA);
            PG8_WAIT_V(8); PG8_WAIT_L(0); PG8_BAR; PG8_MMA(0, 0, At, B0); PG8_MMA(0, 1, At, B1); PG8_BAR; PG8_SCHED;
            PG8_LDA(At, 1, 1); PG8_STAGE(PG8_SB(1, 0), b3, voffB); PG8_STAGE(PG8_SB(1, 1), b3 + hB, voffB); PG8_STAGE(PG8_SA(1, 0), a3, voffA);
            PG8_WAIT_V(8); PG8_WAIT_L(0); PG8_BAR; PG8_MMA(1, 0, At, B0); PG8_MMA(1, 1, At, B1); PG8_BAR; PG8_SCHED;
        }
        if constexpr (ALIGN_EPI) { if (wr == 0) PG8_BAR; }
        { const int ln_ = fresh_lane(); E(acc, cur, wr, wc, ln_ & 15, ln_ >> 4); }
        if (!has_next) break;
#pragma unroll
        for (int a = 0; a < 2; ++a)
#pragma unroll
            for (int b = 0; b < 2; ++b)
#pragma unroll
                for (int m = 0; m < 4; ++m)
#pragma unroll
                    for (int n = 0; n < 2; ++n) acc[a][b][m][n] = (f32x4){0.f, 0.f, 0.f, 0.f};
        cur = nxt; cA = nA; cB = nB; ++ui;
        if constexpr (ALIGN_EPI) { if (wr == 1) PG8_BAR; }
    }
    PG8_WAIT_V(0);
    if constexpr (!ALIGN_EPI) { if (wr == 0) PG8_BAR; }
    PG8_BAR;
#undef PG8_SA
#undef PG8_SB
#undef PG8_STAGE
#undef PG8_LDA
#undef PG8_LDB
#undef PG8_MMA
#undef PG8_WAIT_V
#undef PG8_WAIT_L
#undef PG8_BAR
#undef PG8_SCHED
}
}
#define XB_TMO      128
#define XB_XCNT(j)  (256  + 64 * (j))
#define XB_XSUB(j)  (1280 + 64 * (j))
#define XB_XGEN(j)  (2304 + 64 * (j))
#define XB_TOP      3328
#define XB_TOPGEN   3392
#define XCD_BAR_WORDS 3456
#define XB_SPIN_CAP (1u << 18)
__device__ __forceinline__ unsigned xb_ld(unsigned* p)              { return __hip_atomic_load(p, __ATOMIC_RELAXED, __HIP_MEMORY_SCOPE_AGENT); }
__device__ __forceinline__ unsigned xb_add(unsigned* p, unsigned v) { return __hip_atomic_fetch_add(p, v, __ATOMIC_RELAXED, __HIP_MEMORY_SCOPE_AGENT); }
__device__ __forceinline__ unsigned xb_xcc_id() { return (unsigned)__builtin_amdgcn_s_getreg((3 << 11) | 20) & 0xFu; }
#define XB_SPIN(cond, bar) do { unsigned _sp = 0; while (cond) { __builtin_amdgcn_s_sleep(1); \
    if ((++_sp & 255u) == 0u) { if (xb_ld(&(bar)[XB_TMO])) break; if (_sp > XB_SPIN_CAP) { atomicAdd(&(bar)[XB_TMO], 1u); break; } } } } while (0)
struct XcdBarrier { unsigned* bar; unsigned x; volatile LAS unsigned* st; };
__device__ __forceinline__ XcdBarrier xcd_barrier_post(unsigned* bar, volatile LAS unsigned* st) {
    XcdBarrier b; b.bar = bar; b.x = xb_xcc_id(); b.st = st;
    if (threadIdx.x == 0) (void)xb_add(&bar[XB_XCNT(b.x)], 1u);
    return b;
}
__device__ __forceinline__ void xcd_barrier_complete(unsigned* bar, unsigned x, unsigned& nloc, unsigned& nx) {
    const unsigned G = gridDim.x * gridDim.y * gridDim.z;
    unsigned sum, cnt, mine, sp = 0u;
    for (;;) {
        sum = 0u; cnt = 0u; mine = 0u;
#pragma unroll
        for (unsigned j = 0; j < 16; ++j) { const unsigned c = xb_ld(&bar[XB_XCNT(j)]); sum += c; cnt += (c > 0u) ? 1u : 0u; mine = (j == x) ? c : mine; }
        if (sum == G) break;
        __builtin_amdgcn_s_sleep(1);
        if ((++sp & 255u) == 0u) { if (xb_ld(&bar[XB_TMO])) break; if (sp > XB_SPIN_CAP) { atomicAdd(&bar[XB_TMO], 1u); break; } }
    }
    nloc = mine > 0u ? mine : 1u; nx = cnt > 0u ? cnt : 1u;
}
__device__ __forceinline__ void xcd_barrier(const XcdBarrier& b) {
    asm volatile("s_waitcnt vmcnt(0)" ::: "memory");
    __syncthreads();
    if (threadIdx.x == 0) {
        unsigned* bar = b.bar; unsigned bx = b.x; asm volatile("" : "+s"(bar), "+s"(bx));
        __builtin_amdgcn_s_waitcnt(0);
        const unsigned nloc = b.st[0], nx = b.st[1];
        const unsigned old = xb_add(&bar[XB_XSUB(bx)], 1u);
        const unsigned gen = old / nloc;
        if (old + 1u == (gen + 1u) * nloc) {
            __builtin_amdgcn_fence(__ATOMIC_RELEASE, "agent");
            asm volatile("s_waitcnt vmcnt(0)" ::: "memory");
            const unsigned og = xb_add(&bar[XB_TOP], 1u);
            const unsigned tg = og / nx;
            if (og + 1u == (tg + 1u) * nx) xb_add(&bar[XB_TOPGEN], 1u);
            else XB_SPIN(xb_ld(&bar[XB_TOPGEN]) == tg, bar);
            __builtin_amdgcn_fence(__ATOMIC_ACQUIRE, "agent");
            xb_add(&bar[XB_XGEN(bx)], 1u);
            asm volatile("s_waitcnt vmcnt(0)" ::: "memory");
        } else {
            XB_SPIN(xb_ld(&bar[XB_XGEN(bx)]) == gen, bar);
            __builtin_amdgcn_fence(__ATOMIC_ACQUIRE, "agent");
            asm volatile("s_waitcnt vmcnt(0)" ::: "memory");
        }
    }
    __syncthreads();
}

__device__ __forceinline__ void xcd_barrier_census(const XcdBarrier& b) {
    if (threadIdx.x == 0) { unsigned nloc, nx; xcd_barrier_complete(b.bar, b.x, nloc, nx); b.st[0] = nloc; b.st[1] = nx; }
    __syncthreads();
}

struct Args { const float* in[33]; float* out; unsigned char* ws; int ph_lo, ph_hi; };
enum { I_XP = 0, I_XS, I_CK, I_CV, I_CKI, I_SH, I_SLC, I_SCC, I_SPL, I_WIN, I_LCW, I_LCB, I_LWR, I_LBR, I_LWI, I_LBI, I_LAM, I_CCW, I_CCB, I_CLG, I_CLB, I_PW, I_PSC, I_WBR, I_WOUT,
       I_LN1G, I_LN1B, I_WQ, I_SUBK, I_PU, I_PV, I_LN2G, I_LN2B };

__device__ __forceinline__ Args load_args() {
    typedef const __attribute__((address_space(4))) unsigned long long* kp_t;
    kp_t kp = (kp_t)__builtin_amdgcn_kernarg_segment_ptr(); asm volatile("" : "+s"(kp));
    Args a;
    typedef __attribute__((address_space(1))) float* gf_t;
#pragma unroll
    for (int i = 0; i < 33; ++i) a.in[i] = (const float*)(gf_t)kp[i];
    a.out = (float*)(gf_t)kp[33]; a.ws = (unsigned char*)(__attribute__((address_space(1))) unsigned char*)kp[34]; a.ph_lo = 0; a.ph_hi = 0;
    return a;
}

struct RowI { int b, t, tail, pos; };
__device__ __forceinline__ RowI rowinfo(int r) { RowI o; if (r < MP) { o.b = r >> 12; o.t = r & 4095; o.tail = 4095 - o.t; o.pos = o.t; } else { const int rr = r - MP; o.b = rr >> 6; o.t = rr & 63; o.tail = 63 - o.t; o.pos = PAST + o.t; } return o; }

__device__ __forceinline__ int win_src(int j) {
    if (j < 2048) return j;
    if (j < 4096) { const int tt = (j - 2048) >> 8, w = (j - 2048) & 255; return w < 128 ? 2048 + 128 * tt + w : 3072 + 128 * tt + (w - 128); }
    if (j < 6216) return j;
    if (j < 6400) return -1;
    if (j < 7424) return 6216 + (j - 6400);
    return 7240 + (j - 7424);
}

struct EpiWin {
    static constexpr bool PERM = false;
    unsigned char* ws; float* out; int l;
    __device__ __forceinline__ void operator()(const f32x4 (&acc)[2][2][4][2], const pg8::Unit& u, int wr, int wc, int fr, int fq) const {
        asm volatile("" : "+v"(fr), "+v"(fq));
        const int pn = u.pn; const int rbase = u.pm * 256 + wr * 64 + fr; const bool samp = rbase >= MP;
        const int cl = wc * 32 + 4 * fq;
        if (pn < 4) {
            bf16_t* ZA = (bf16_t*)(ws + WS_ZA);
#pragma unroll
            for (int ai = 0; ai < 2; ++ai)
#pragma unroll
                for (int m = 0; m < 4; ++m) { const int r = rbase + ai * 128 + m * 16; const RowI ri = rowinfo(r);
#pragma unroll
                    for (int bj = 0; bj < 2; ++bj)
#pragma unroll
                        for (int n = 0; n < 2; ++n) { const f32x4 v = acc[ai][bj][m][n]; const int c = pn * 256 + bj * 128 + cl + n * 16;
                            *(u32x2*)(ZA + (size_t)r * WL + c) = (u32x2){pk2(v[0], v[1]), pk2(v[2], v[3])};
                            if (ri.tail < 3) { float* o = samp ? out + O_LCS + ((size_t)(l * DB + ri.b) * 3 + (2 - ri.tail)) * WL : out + O_LCP + ((size_t)(l * 2 + ri.b) * 3 + (2 - ri.tail)) * WL; *(f32x4*)(o + c) = v; } } }
        } else if (pn < 8) {
            bf16_t* GZ = (bf16_t*)(ws + WS_GZ);
#pragma unroll
            for (int ai = 0; ai < 2; ++ai)
#pragma unroll
                for (int m = 0; m < 4; ++m) { const int r = rbase + ai * 128 + m * 16;
#pragma unroll
                    for (int bj = 0; bj < 2; ++bj)
#pragma unroll
                        for (int n = 0; n < 2; ++n) { const f32x4 v = acc[ai][bj][m][n]; const int c = (pn - 4) * 256 + bj * 128 + cl + n * 16;
                            *(u32x2*)(GZ + (size_t)r * WL + c) = (u32x2){pk2(gelu_tanh(v[0]), gelu_tanh(v[1])), pk2(gelu_tanh(v[2]), gelu_tanh(v[3]))}; } }
        } else if (pn < 16) {
            bf16_t* GLU = (bf16_t*)(ws + WS_GLU);
#pragma unroll
            for (int ai = 0; ai < 2; ++ai)
#pragma unroll
                for (int m = 0; m < 4; ++m) { const int r = rbase + ai * 128 + m * 16; const RowI ri = rowinfo(r);
#pragma unroll
                    for (int n = 0; n < 2; ++n) { const f32x4 a = acc[ai][0][m][n], g = acc[ai][1][m][n]; f32x4 v;
#pragma unroll
                        for (int j = 0; j < 4; ++j) v[j] = a[j] * sigmoidf_(g[j]);
                        const int c = (pn - 8) * 128 + cl + n * 16;
                        *(u32x2*)(GLU + (size_t)r * WL + c) = (u32x2){pk2(v[0], v[1]), pk2(v[2], v[3])};
                        if (ri.tail < 30) { float* o = samp ? out + O_CCS + ((size_t)(l * DB + ri.b) * 30 + (29 - ri.tail)) * WL : out + O_CCP + ((size_t)(l * 2 + ri.b) * 30 + (29 - ri.tail)) * WL; *(f32x4*)(o + c) = v; } } }
        } else if (pn < 22) {
            const float* cosq = (const float*)(ws + WS_ROPE); const float* sinq = cosq + 4096 * 16;
            f32x4 csa[2][4], sna[2][4];
#pragma unroll
            for (int ai = 0; ai < 2; ++ai)
#pragma unroll
                for (int m = 0; m < 4; ++m) { const RowI ri = rowinfo(rbase + ai * 128 + m * 16);
                    csa[ai][m] = (f32x4){1.f, 1.f, 1.f, 1.f}; sna[ai][m] = (f32x4){0.f, 0.f, 0.f, 0.f};
                    if (wc == 0 && pn != 21) { csa[ai][m] = *(const f32x4*)(cosq + ri.pos * 16 + 4 * fq); sna[ai][m] = *(const f32x4*)(sinq + ri.pos * 16 + 4 * fq); } }
#pragma unroll
            for (int ai = 0; ai < 2; ++ai)
#pragma unroll
                for (int m = 0; m < 4; ++m) { const int r = rbase + ai * 128 + m * 16; const RowI ri = rowinfo(r);
                    const f32x4 cs = csa[ai][m], sn = sna[ai][m];
#pragma unroll
                    for (int bj = 0; bj < 2; ++bj) { f32x4 v0 = acc[ai][bj][m][0], v1 = acc[ai][bj][m][1];
                        if (wc == 0 && pn != 21) { const f32x4 x1 = v0, x2 = v1; v0 = x1 * cs - x2 * sn; v1 = x2 * cs + x1 * sn; }
                        const int c = bj * 128 + cl;
                        if (pn < 20) { bf16_t* Q = (bf16_t*)(ws + WS_Q) + (size_t)r * WL + (pn - 16) * 256 + c;
                            *(u32x2*)(Q) = (u32x2){pk2(v0[0] * QSCALE, v0[1] * QSCALE), pk2(v0[2] * QSCALE, v0[3] * QSCALE)};
                            *(u32x2*)(Q + 16) = (u32x2){pk2(v1[0] * QSCALE, v1[1] * QSCALE), pk2(v1[2] * QSCALE, v1[3] * QSCALE)};
                        } else {
                            const bool isk = (pn == 20);
                            bf16_t* dst = samp ? (bf16_t*)(ws + (isk ? WS_KS : WS_VS)) + ((size_t)ri.b * SKS + PAST + ri.t) * 256 + c : (bf16_t*)(ws + (isk ? WS_KP : WS_VP)) + (size_t)r * 256 + c;
                            *(u32x2*)(dst) = (u32x2){pk2(v0[0], v0[1]), pk2(v0[2], v0[3])}; *(u32x2*)(dst + 16) = (u32x2){pk2(v1[0], v1[1]), pk2(v1[2], v1[3])};
                            float* o = samp ? out + (isk ? O_KS : O_VS) + ((size_t)(l * DB + ri.b) * DSQ + ri.t) * 256 + c : out + (isk ? O_KP : O_VP) + ((size_t)(l * 2 + ri.b) * SEQ + ri.t) * 256 + c;
                            *(f32x4*)(o) = v0; *(f32x4*)(o + 16) = v1; } } }
        } else if (pn < 25) {
            const float* cosi = (const float*)(ws + WS_ROPE) + 4096 * 32; const float* sini = cosi + 4096 * 8;
            const bool rot = (wc & 1) == 0;
            f32x4 csa[2][4], sna[2][4];
#pragma unroll
            for (int ai = 0; ai < 2; ++ai)
#pragma unroll
                for (int m = 0; m < 4; ++m) { const RowI ri = rowinfo(rbase + ai * 128 + m * 16);
                    csa[ai][m] = (f32x4){1.f, 1.f, 1.f, 1.f}; sna[ai][m] = (f32x4){0.f, 0.f, 0.f, 0.f};
                    if (rot) { csa[ai][m] = *(const f32x4*)(cosi + ri.pos * 8 + 4 * (fq & 1)); sna[ai][m] = *(const f32x4*)(sini + ri.pos * 8 + 4 * (fq & 1)); } }
#pragma unroll
            for (int ai = 0; ai < 2; ++ai)
#pragma unroll
                for (int m = 0; m < 4; ++m) { const int r = rbase + ai * 128 + m * 16; const RowI ri = rowinfo(r);
                    const f32x4 cs = csa[ai][m], sn = sna[ai][m];
#pragma unroll
                    for (int bj = 0; bj < 2; ++bj) { f32x4 v0 = acc[ai][bj][m][0]; const f32x4 v1 = acc[ai][bj][m][1];
                        if (rot) { f32x4 p;
#pragma unroll
                            for (int j = 0; j < 4; ++j) p[j] = shflx(v0[j], 32);
                            if (fq < 2) v0 = v0 * cs - p * sn; else v0 = v0 * cs + p * sn; }
                        if (pn < 24) { bf16_t* QI = (bf16_t*)(ws + WS_QI) + (size_t)r * 512 + (pn - 22) * 256 + bj * 128 + cl;
                            *(u32x2*)(QI) = (u32x2){pk2(v0[0], v0[1]), pk2(v0[2], v0[3])}; *(u32x2*)(QI + 16) = (u32x2){pk2(v1[0], v1[1]), pk2(v1[2], v1[3])};
                        } else if (bj == 0) {
                            if (wc < 2) { bf16_t* dst = samp ? (bf16_t*)(ws + WS_KIS) + ((size_t)ri.b * SKS + PAST + ri.t) * 64 + cl : (bf16_t*)(ws + WS_KIP) + (size_t)r * 64 + cl;
                                *(u32x2*)(dst) = (u32x2){pk2(v0[0], v0[1]), pk2(v0[2], v0[3])}; *(u32x2*)(dst + 16) = (u32x2){pk2(v1[0], v1[1]), pk2(v1[2], v1[3])};
                                float* o = samp ? out + O_KIS + ((size_t)(l * DB + ri.b) * DSQ + ri.t) * 64 + cl : out + O_KIP + ((size_t)(l * 2 + ri.b) * SEQ + ri.t) * 64 + cl;
                                *(f32x4*)(o) = v0; *(f32x4*)(o + 16) = v1;
                            } else if (wc == 2 && fq < 2) { *(f32x4*)((float*)(ws + WS_WI) + (size_t)r * 8 + 4 * fq) = acc[ai][0][m][0]; } } } }
        } else if (pn < 29) {
            bf16_t* ZP = (bf16_t*)(ws + WS_ZP);
#pragma unroll
            for (int ai = 0; ai < 2; ++ai)
#pragma unroll
                for (int m = 0; m < 4; ++m) { const int r = rbase + ai * 128 + m * 16; const RowI ri = rowinfo(r);
#pragma unroll
                    for (int bj = 0; bj < 2; ++bj)
#pragma unroll
                        for (int n = 0; n < 2; ++n) { const f32x4 v = acc[ai][bj][m][n]; const int c = (pn - 25) * 256 + bj * 128 + cl + n * 16;
                            *(u32x2*)(ZP + (size_t)r * WL + c) = (u32x2){pk2(v[0], v[1]), pk2(v[2], v[3])};
                            if (ri.tail < 15) { float* o = samp ? out + O_PS + ((size_t)(l * DB + ri.b) * 15 + (14 - ri.tail)) * WL : out + O_PP + ((size_t)(l * 2 + ri.b) * 15 + (14 - ri.tail)) * WL; *(f32x4*)(o + c) = v; } } }
        } else {
            unsigned char* GT = ws + WS_GATES;
#pragma unroll
            for (int ai = 0; ai < 2; ++ai)
#pragma unroll
                for (int m = 0; m < 4; ++m) { const int r = rbase + ai * 128 + m * 16;
#pragma unroll
                    for (int bj = 0; bj < 2; ++bj)
#pragma unroll
                        for (int n = 0; n < 2; ++n) { const f32x4 v = acc[ai][bj][m][n]; const int c = (pn - 29) * 256 + bj * 128 + cl + n * 16;
                            *(unsigned*)(GT + (size_t)r * 8192 + c) = pk4_u8(sig255(v[0]), sig255(v[1]), sig255(v[2]), sig255(v[3])); } }
        }
    }
};

struct EpiGates {
    static constexpr bool PERM = true;
    unsigned char* ws;
    __device__ __forceinline__ void operator()(const f32x4 (&acc)[2][2][4][2], const pg8::Unit& u, int wr, int wc, int fr, int fq) const {
        asm volatile("" : "+v"(fr), "+v"(fq));
        const int row0 = u.pm * 256 + wr * 64 + fr, col0 = u.pn * 256 + wc * 32 + 8 * fq; constexpr float GSC = 1.0f / 64.0f;
        unsigned char* GT = ws + WS_GATES;
#pragma unroll
        for (int ai = 0; ai < 2; ++ai)
#pragma unroll
            for (int m = 0; m < 4; ++m) { const int r = row0 + ai * 128 + m * 16;
#pragma unroll
                for (int bj = 0; bj < 2; ++bj) { const f32x4 v0 = acc[ai][bj][m][0], v1 = acc[ai][bj][m][1];
                    *(u32x2*)(GT + (size_t)r * 8192 + col0 + bj * 128) = (u32x2){pk4_u8(sig255(v0[0] * GSC), sig255(v0[1] * GSC), sig255(v0[2] * GSC), sig255(v0[3] * GSC)), pk4_u8(sig255(v1[0] * GSC), sig255(v1[1] * GSC), sig255(v1[2] * GSC), sig255(v1[3] * GSC))}; } }
    }
};

struct EpiPool {
    static constexpr bool PERM = true;
    unsigned char* Y3; const float* scale;
    __device__ __forceinline__ void operator()(const f32x4 (&acc)[2][2][4][2], const pg8::Unit& u, int wr, int wc, int fr, int fq) const {
        asm volatile("" : "+v"(fr), "+v"(fq));
        const int row0 = u.pm * 256 + wr * 64 + fr, col0 = u.z * 256 + wc * 32 + 8 * fq;
        f32x4 sc0[2], sc1[2];
#pragma unroll
        for (int bj = 0; bj < 2; ++bj) { sc0[bj] = *(const f32x4*)(scale + col0 + bj * 128); sc1[bj] = *(const f32x4*)(scale + col0 + bj * 128 + 4); }
#pragma unroll
        for (int bj = 0; bj < 2; ++bj) { const f32x4 s0 = sc0[bj], s1 = sc1[bj];
#pragma unroll
            for (int ai = 0; ai < 2; ++ai)
#pragma unroll
                for (int m = 0; m < 4; ++m) { const f32x4 v0 = acc[ai][bj][m][0] * s0, v1 = acc[ai][bj][m][1] * s1;
                    *(u32x2*)(Y3 + (size_t)(row0 + ai * 128 + m * 16) * WL + col0 + bj * 128) = (u32x2){pk4_fp8(v0), pk4_fp8(v1)}; } }
    }
};

struct EpiGate {
    static constexpr bool PERM = true;
    bf16_t* PG; const unsigned char* GT;
    __device__ __forceinline__ void operator()(const f32x4 (&acc)[2][2][4][2], const pg8::Unit& u, int wr, int wc, int fr, int fq) const {
        asm volatile("" : "+v"(fr), "+v"(fq));
        const int row0 = u.pm * 256 + wr * 64 + fr, col0 = u.pn * 256 + wc * 32 + 8 * fq;
        u32x2 gg[2][4][2];
#pragma unroll
        for (int ai = 0; ai < 2; ++ai)
#pragma unroll
            for (int m = 0; m < 4; ++m)
#pragma unroll
                for (int bj = 0; bj < 2; ++bj) gg[ai][m][bj] = *(const u32x2*)(GT + (size_t)(row0 + ai * 128 + m * 16) * 8192 + u.z * 2048 + col0 + bj * 128);
#pragma unroll
        for (int ai = 0; ai < 2; ++ai)
#pragma unroll
            for (int m = 0; m < 4; ++m) { const int r = row0 + ai * 128 + m * 16;
#pragma unroll
                for (int bj = 0; bj < 2; ++bj) { const u32x2 g = gg[ai][m][bj];
                    const f32x4 v0 = acc[ai][bj][m][0] * (1.0f / 32.0f), v1 = acc[ai][bj][m][1] * (1.0f / 32.0f);
                    u32x4 w; w.x = pk2(v0[0] * gate_u8(g.x, 0), v0[1] * gate_u8(g.x, 1)); w.y = pk2(v0[2] * gate_u8(g.x, 2), v0[3] * gate_u8(g.x, 3)); w.z = pk2(v1[0] * gate_u8(g.y, 0), v1[1] * gate_u8(g.y, 1)); w.w = pk2(v1[2] * gate_u8(g.y, 2), v1[3] * gate_u8(g.y, 3));
                    *(u32x4*)(PG + ((size_t)u.z * M + r) * D + col0 + bj * 128) = w; } }
    }
};

struct EpiOut {
    static constexpr bool PERM = false;
    const float* xp; const float* xs; const bf16_t* xb; bf16_t* pre;
    __device__ __forceinline__ void operator()(const f32x4 (&acc)[2][2][4][2], const pg8::Unit& u, int wr, int wc, int fr, int fq) const {
        asm volatile("" : "+v"(fr), "+v"(fq));
        const int row0 = u.pm * 256 + wr * 64 + fr, col0 = u.pn * 256 + wc * 32 + 4 * fq;
        if (xb) {
            u32x2 xw[2][4][2][2];
#pragma unroll
            for (int ai = 0; ai < 2; ++ai)
#pragma unroll
                for (int m = 0; m < 4; ++m)
#pragma unroll
                    for (int bj = 0; bj < 2; ++bj)
#pragma unroll
                        for (int n = 0; n < 2; ++n) xw[ai][m][bj][n] = *(const u32x2*)(xb + (size_t)(row0 + ai * 128 + m * 16) * D + col0 + bj * 128 + n * 16);
#pragma unroll
            for (int ai = 0; ai < 2; ++ai)
#pragma unroll
                for (int m = 0; m < 4; ++m) { const int r = row0 + ai * 128 + m * 16;
#pragma unroll
                    for (int bj = 0; bj < 2; ++bj)
#pragma unroll
                        for (int n = 0; n < 2; ++n) { const int c = col0 + bj * 128 + n * 16; const u32x2 w = xw[ai][m][bj][n];
                            const f32x4 y = (f32x4){bflo(w.x), bfhi(w.x), bflo(w.y), bfhi(w.y)} * ALPHA + acc[ai][bj][m][n];
                            *(u32x2*)(pre + (size_t)r * D + c) = (u32x2){pk2(y[0], y[1]), pk2(y[2], y[3])}; } }
        } else {
            const float* xrow = (u.pm * 256 < MP) ? xp + (size_t)row0 * D : xs + (size_t)(row0 - MP) * D;
#pragma unroll
            for (int ai = 0; ai < 2; ++ai) {
                f32x4 xv[4][2][2];
#pragma unroll
                for (int m = 0; m < 4; ++m)
#pragma unroll
                    for (int bj = 0; bj < 2; ++bj)
#pragma unroll
                        for (int n = 0; n < 2; ++n) xv[m][bj][n] = *(const f32x4*)(xrow + (size_t)(ai * 128 + m * 16) * D + col0 + bj * 128 + n * 16);
#pragma unroll
                for (int m = 0; m < 4; ++m) { const int r = row0 + ai * 128 + m * 16;
#pragma unroll
                    for (int bj = 0; bj < 2; ++bj)
#pragma unroll
                        for (int n = 0; n < 2; ++n) { const int c = col0 + bj * 128 + n * 16;
                            const f32x4 y = xv[m][bj][n] * ALPHA + acc[ai][bj][m][n];
                            *(u32x2*)(pre + (size_t)r * D + c) = (u32x2){pk2(y[0], y[1]), pk2(y[2], y[3])}; } }
            }
        }
    }
};

struct EpiQ {
    static constexpr bool PERM = true;
    bf16_t* QP;
    __device__ __forceinline__ void operator()(const f32x4 (&acc)[2][2][4][2], const pg8::Unit& u, int wr, int wc, int fr, int fq) const {
        asm volatile("" : "+v"(fr), "+v"(fq));
        const int row0 = u.pm * 256 + wr * 64 + fr, col0 = u.pn * 256 + wc * 32 + 8 * fq;
#pragma unroll
        for (int ai = 0; ai < 2; ++ai)
#pragma unroll
            for (int m = 0; m < 4; ++m)
#pragma unroll
                for (int bj = 0; bj < 2; ++bj) { const f32x4 v0 = acc[ai][bj][m][0], v1 = acc[ai][bj][m][1];
                    u32x4 w; w.x = pk2(v0[0], v0[1]); w.y = pk2(v0[2], v0[3]); w.z = pk2(v1[0], v1[1]); w.w = pk2(v1[2], v1[3]);
                    *(u32x4*)(QP + (size_t)(row0 + ai * 128 + m * 16) * D + col0 + bj * 128) = w; }
    }
};

struct PoolOrder {
    int G, c;
    __device__ bool next(int i, pg8::Unit& u) const { const int L = i * G + c; if (L >= 160) return false; u.pm = L >> 2; u.z = L & 3; u.pn = 0;
        u.aoff = ((size_t)u.pm * 256 * WL + u.z * 256) * 2; u.boff = (size_t)u.z * 256 * 256 * 2; return true; }
};
struct BranchOrder {
    int G, c;
    __device__ bool next(int i, pg8::Unit& u) const { const int L = i * G + c; if (L >= 1280) return false; const int z = L / 320, t = L % 320; u.z = z; u.pm = t % 40; u.pn = t / 40;
        u.aoff = ((size_t)z * M + (size_t)u.pm * 256) * WL; u.boff = ((size_t)z * 2048 + (size_t)u.pn * 256) * WL; return true; }
};
struct Frame { LAS unsigned char* lds; unsigned char* ws; unsigned* ctl; int tid, lane, wave, G, bid; };

struct ItemQ { int nxt; };
__device__ __forceinline__ int q_first(const Frame& F, int cw, ItemQ& q) {
    volatile LAS int* slot = (volatile LAS int*)(F.lds + LDS_MISC + 64);
    const bool me = (F.wave == 0 && fresh_lane() == 0);
    __syncthreads();
    if (me) { *slot = (int)__hip_atomic_fetch_add(F.ctl + cw, 1u, __ATOMIC_RELAXED, __HIP_MEMORY_SCOPE_AGENT); }
    __syncthreads();
    const int cur = *slot;
    q.nxt = 0; if (me) q.nxt = (int)__hip_atomic_fetch_add(F.ctl + cw, 1u, __ATOMIC_RELAXED, __HIP_MEMORY_SCOPE_AGENT);
    return cur;
}
__device__ __forceinline__ int q_block(const Frame& F, int cw) {
    volatile LAS int* slot = (volatile LAS int*)(F.lds + LDS_MISC + 64);
    __syncthreads();
    if (F.wave == 0 && fresh_lane() == 0) *slot = (int)__hip_atomic_fetch_add(F.ctl + cw, 1u, __ATOMIC_RELAXED, __HIP_MEMORY_SCOPE_AGENT);
    __syncthreads();
    return *slot;
}
__device__ __forceinline__ int q_next(const Frame& F, int cw, ItemQ& q) {
    volatile LAS int* slot = (volatile LAS int*)(F.lds + LDS_MISC + 64);
    const bool me = (F.wave == 0 && fresh_lane() == 0);
    __syncthreads();
    if (me) { *slot = q.nxt; q.nxt = (int)__hip_atomic_fetch_add(F.ctl + cw, 1u, __ATOMIC_RELAXED, __HIP_MEMORY_SCOPE_AGENT); }
    __syncthreads();
    return *slot;
}
constexpr int CW_ITEM = 8192;

template <class MapFn>
__device__ __forceinline__ void transpose_mat(const Frame& F, const float* W, int ldw, bf16_t* WT, int K, int Ndst, MapFn map) {
    LAS float* scr = (LAS float*)(F.lds + F.wave * 16640);
    const int gw = F.bid * NWAVES + F.wave, NGW = F.G * NWAVES, lane = F.lane;
    const int nblk = Ndst / 64, nitems = (K / 64) * nblk;
    const int cq = lane & 15, rq = lane >> 4;
    for (int it = gw; it < nitems; it += NGW) {
        const int kb = it / nblk, nb = it % nblk, k0 = 64 * kb, n0 = 64 * nb;
        const int sc = map(n0 + 4 * cq);
        f32x4 v[16];
#pragma unroll
        for (int i = 0; i < 16; ++i) v[i] = sc >= 0 ? *(const f32x4*)(W + (size_t)(k0 + rq + 4 * i) * ldw + sc) : (f32x4){0.f, 0.f, 0.f, 0.f};
#pragma unroll
        for (int i = 0; i < 16; ++i) { const int kk = rq + 4 * i;
#pragma unroll
            for (int e = 0; e < 4; ++e) scr[(4 * cq + e) * 65 + kk] = v[i][e]; }
        asm volatile("s_waitcnt lgkmcnt(0)" ::: "memory");
        const int c8 = lane & 7;
#pragma unroll
        for (int j = 0; j < 8; ++j) { const int n = (lane >> 3) + 8 * j; const LAS float* s = scr + n * 65 + 8 * c8;
            u32x4 o; o.x = pk2(s[0], s[1]); o.y = pk2(s[2], s[3]); o.z = pk2(s[4], s[5]); o.w = pk2(s[6], s[7]);
            *(u32x4*)(WT + (size_t)(n0 + n) * K + k0 + 8 * c8) = o; }
        asm volatile("s_waitcnt lgkmcnt(0)" ::: "memory");
    }
}
__device__ __forceinline__ void transpose_mat8(const Frame& F, const float* W, int ldw, unsigned char* WT, int K, int Ndst, float wsc = 64.0f) {
    LAS float* scr = (LAS float*)(F.lds + F.wave * 16640);
    const int gw = F.bid * NWAVES + F.wave, NGW = F.G * NWAVES, lane = F.lane;
    const int nblk = Ndst / 64, nitems = (K / 64) * nblk;
    const int cq = lane & 15, rq = lane >> 4;
    for (int it = gw; it < nitems; it += NGW) {
        const int kb = it / nblk, nb = it % nblk, k0 = 64 * kb, n0 = 64 * nb;
        f32x4 v[16];
#pragma unroll
        for (int i = 0; i < 16; ++i) v[i] = *(const f32x4*)(W + (size_t)(k0 + rq + 4 * i) * ldw + n0 + 4 * cq);
#pragma unroll
        for (int i = 0; i < 16; ++i) { const int kk = rq + 4 * i;
#pragma unroll
            for (int e = 0; e < 4; ++e) scr[(4 * cq + e) * 65 + kk] = v[i][e] * wsc; }
        asm volatile("s_waitcnt lgkmcnt(0)" ::: "memory");
        const int c8 = lane & 7;
#pragma unroll
        for (int j = 0; j < 8; ++j) { const int n = (lane >> 3) + 8 * j; const LAS float* s = scr + n * 65 + 8 * c8;
            int w0 = 0, w1 = 0;
            w0 = __builtin_amdgcn_cvt_pk_fp8_f32(s[0], s[1], w0, false); w0 = __builtin_amdgcn_cvt_pk_fp8_f32(s[2], s[3], w0, true);
            w1 = __builtin_amdgcn_cvt_pk_fp8_f32(s[4], s[5], w1, false); w1 = __builtin_amdgcn_cvt_pk_fp8_f32(s[6], s[7], w1, true);
            *(u32x2*)(WT + (size_t)(n0 + n) * K + k0 + 8 * c8) = (u32x2){(unsigned)w0, (unsigned)w1}; }
        asm volatile("s_waitcnt lgkmcnt(0)" ::: "memory");
    }
}
struct MapId { __device__ __forceinline__ int operator()(int j) const { return j; } };
struct MapWin { __device__ __forceinline__ int operator()(int j) const { return win_src(j); } };

__device__ __forceinline__ void cvt_rows(const Frame& F, const float* src, bf16_t* dst, size_t n4, int nb, size_t sbs, size_t dbs, unsigned char* dst8 = nullptr) {
    const size_t total = n4 * nb, stride = (size_t)F.G * NTHREADS;
    size_t i = (size_t)F.bid * NTHREADS + F.tid;
    for (; i + 7 * stride < total; i += 8 * stride) {
        f32x4 v[8]; size_t off[8];
#pragma unroll
        for (int u = 0; u < 8; ++u) { const size_t ii = i + u * stride, b = ii / n4, j = ii - b * n4; v[u] = *(const f32x4*)(src + b * sbs + 4 * j); off[u] = b * dbs + 4 * j; }
#pragma unroll
        for (int u = 0; u < 8; ++u) { *(u32x2*)(dst + off[u]) = (u32x2){pk2(v[u][0], v[u][1]), pk2(v[u][2], v[u][3])}; if (dst8) *(unsigned*)(dst8 + off[u]) = pk4_fp8(v[u]); }
    }
    for (; i < total; i += stride) { const size_t b = i / n4, j = i - b * n4;
        const f32x4 v = *(const f32x4*)(src + b * sbs + 4 * j); *(u32x2*)(dst + b * dbs + 4 * j) = (u32x2){pk2(v[0], v[1]), pk2(v[2], v[3])}; if (dst8) *(unsigned*)(dst8 + b * dbs + 4 * j) = pk4_fp8(v); }
}
__device__ __forceinline__ void cvt_table_fp8(const Frame& F, const float* src, unsigned char* dst, float* scl, int nrows) {
    const int lane = F.lane;
    for (int r = F.bid * NWAVES + F.wave; r < nrows; r += F.G * NWAVES) {
        f32x4 v[8]; float mx = 0.f;
#pragma unroll
        for (int j = 0; j < 2; ++j)
#pragma unroll
            for (int q = 0; q < 4; ++q) { v[4 * j + q] = *(const f32x4*)(src + (size_t)r * D + 1024 * j + 16 * lane + 4 * q);
                mx = fmaxf(mx, fmaxf(fmaxf(fabsf(v[4 * j + q][0]), fabsf(v[4 * j + q][1])), fmaxf(fabsf(v[4 * j + q][2]), fabsf(v[4 * j + q][3])))); }
        mx = wave_max_dpp(mx);
        const float sc = (mx > 0.f) ? mx * (1.0f / 448.0f) : 1.0f, inv = 1.0f / sc;
#pragma unroll
        for (int j = 0; j < 2; ++j) { u32x4 o;
#pragma unroll
            for (int q = 0; q < 4; ++q) { const f32x4 x = v[4 * j + q] * inv; int w = __builtin_amdgcn_cvt_pk_fp8_f32(x[0], x[1], 0, false); w = __builtin_amdgcn_cvt_pk_fp8_f32(x[2], x[3], w, true); o[q] = (unsigned)w; }
            *(u32x4*)(dst + (size_t)r * D + 1024 * j + 16 * lane) = o; }
        if (lane == 0) scl[r] = sc;
    }
}
constexpr size_t WS_ESC = WS_U + (size_t)2 * NEXP * 1024;
static_assert(WS_ESC + (size_t)2 * NEXP * 128 <= WS_WIN8, "exponent bytes overlap the fp8 gate weights");
constexpr size_t WS_V4S = WS_V + (size_t)2 * NEXP * 1024;
__device__ __forceinline__ void cvt_table_fp4(const Frame& F, const float* src, unsigned char* dst, unsigned char* sce, int nrows) {
    const int lane = F.lane;
    for (int r = F.bid * NWAVES + F.wave; r < nrows; r += F.G * NWAVES) {
        f32x4 v[8]; float mx = 0.f;
#pragma unroll
        for (int q = 0; q < 8; ++q) { v[q] = *(const f32x4*)(src + (size_t)r * D + 32 * lane + 4 * q);
            mx = fmaxf(mx, fmaxf(fmaxf(fabsf(v[q][0]), fabsf(v[q][1])), fmaxf(fabsf(v[q][2]), fabsf(v[q][3])))); }
        unsigned e = ((__float_as_uint(mx * (1.0f / 6.0f)) + 0x7FFFFFu) >> 23) & 0xFFu;
        e = e < 1u ? 1u : (e > 253u ? 253u : e);
        const float inv = __uint_as_float((254u - e) << 23);
        u32x4 o;
#pragma unroll
        for (int i = 0; i < 4; ++i) { unsigned w = 0u;
#pragma unroll
            for (int k = 0; k < 8; ++k) { const float x = v[2 * i + (k >> 2)][k & 3]; const float y = fabsf(x) * inv;
                const unsigned code = (y > 0.25f) + (y >= 0.75f) + (y > 1.25f) + (y >= 1.75f) + (y > 2.5f) + (y >= 3.5f) + (y > 5.0f);
                w |= (code | ((__float_as_uint(x) >> 31) << 3)) << (4 * k); }
            o[i] = w; }
        *(u32x4*)(dst + (size_t)r * 1024 + 16 * lane) = o;
        sce[(size_t)r * 128 + lane] = (unsigned char)e;
    }
}
__device__ __forceinline__ void convert_cache(const Frame& F, int l) {
    const Args A = load_args();
    cvt_rows(F, A.in[I_CK] + (size_t)l * DB * PAST * 256, (bf16_t*)(F.ws + WS_KS), (size_t)PAST * 64, DB, (size_t)PAST * 256, (size_t)SKS * 256);
    cvt_rows(F, A.in[I_CV] + (size_t)l * DB * PAST * 256, (bf16_t*)(F.ws + WS_VS), (size_t)PAST * 64, DB, (size_t)PAST * 256, (size_t)SKS * 256);
    cvt_rows(F, A.in[I_CKI] + (size_t)l * DB * PAST * 64, (bf16_t*)(F.ws + WS_KIS), (size_t)PAST * 16, DB, (size_t)PAST * 64, (size_t)SKS * 64);
}
__device__ __forceinline__ void prep_a(const Frame& F, int l) {
    const Args A = load_args(); unsigned char* ws = F.ws;
    transpose_mat(F, A.in[I_WIN] + (size_t)l * D * NPROJ, NPROJ, (bf16_t*)(ws + WS_WIN) + (size_t)l * NPAD * D, D, NT_BF * 256, MapWin());
    transpose_mat8(F, A.in[I_WIN] + (size_t)l * D * NPROJ + 7240, NPROJ, ws + WS_WIN8 + (size_t)l * 8192 * D, D, 8192);
}
__device__ __forceinline__ void prep_a_bf(const Frame& F, int l) { const Args A = load_args(); unsigned char* ws = F.ws;
    transpose_mat(F, A.in[I_WIN] + (size_t)l * D * NPROJ, NPROJ, (bf16_t*)(ws + WS_WIN) + (size_t)l * NPAD * D, D, NT_BF * 256, MapWin()); }
__device__ __forceinline__ void prep_a_f8(const Frame& F, int l) { const Args A = load_args(); unsigned char* ws = F.ws;
    transpose_mat8(F, A.in[I_WIN] + (size_t)l * D * NPROJ + 7240, NPROJ, ws + WS_WIN8 + (size_t)l * 8192 * D, D, 8192); }
__device__ __forceinline__ void prep_b(const Frame& F, int l) {
    const Args A = load_args(); unsigned char* ws = F.ws;
    for (int z = 0; z < 4; ++z) transpose_mat8(F, A.in[I_WBR] + (size_t)(l * 4 + z) * WL * D, D, ws + WS_WBR + (size_t)(l * 4 + z) * D * WL, WL, D, 32.0f);
    transpose_mat(F, A.in[I_WOUT] + (size_t)l * D * D, D, (bf16_t*)(ws + WS_WOUT) + (size_t)l * D * D, D, D, MapId());
    transpose_mat(F, A.in[I_WQ] + (size_t)l * D * D, D, (bf16_t*)(ws + WS_WQ) + (size_t)l * D * D, D, D, MapId());
    for (int g = 0; g < 4; ++g) transpose_mat(F, A.in[I_PW] + (size_t)(l * 4 + g) * 256 * 256, 256, (bf16_t*)(ws + WS_POOLT) + (size_t)(l * 4 + g) * 256 * 256, 256, 256, MapId());
    for (int n = 0; n < 16; ++n) { transpose_mat(F, A.in[I_LWR] + (size_t)(l * 16 + n) * 4096, 64, (bf16_t*)(ws + WS_LRUW) + (size_t)((l * 2 + 0) * 16 + n) * 4096, 64, 64, MapId());
                                   transpose_mat(F, A.in[I_LWI] + (size_t)(l * 16 + n) * 4096, 64, (bf16_t*)(ws + WS_LRUW) + (size_t)((l * 2 + 1) * 16 + n) * 4096, 64, 64, MapId()); }
    cvt_rows(F, A.in[I_SUBK] + (size_t)l * 8 * 2 * 128 * 128, (bf16_t*)(ws + WS_SK) + (size_t)l * 8 * 2 * 128 * 128, (size_t)8 * 2 * 128 * 128 / 4, 1, 0, 0);
}
__device__ __forceinline__ void prep_u(const Frame& F, int l) {
    const Args A = load_args(); unsigned char* ws = F.ws;
    cvt_table_fp4(F, A.in[I_PU] + (size_t)l * NEXP * D, ws + WS_U + (size_t)l * NEXP * 1024, ws + WS_ESC + (size_t)l * NEXP * 128, NEXP);
}
__device__ __forceinline__ void prep_c(const Frame& F, int l) {
    const Args A = load_args(); unsigned char* ws = F.ws;
    cvt_table_fp4(F, A.in[I_PV] + (size_t)l * NEXP * D, ws + WS_V + (size_t)l * NEXP * 1024, ws + WS_ESC + (size_t)l * NEXP * 128 + 64, NEXP);
}
__device__ __forceinline__ void p0_prologue(const Frame& F) {
    unsigned char* ws = F.ws;
    prep_a(F, 0);
    { const Args A = load_args();
    cvt_rows(F, A.in[I_XP], (bf16_t*)(ws + WS_XB), (size_t)MP * D / 4, 1, 0, 0, ws + WS_XB8);
    cvt_rows(F, A.in[I_XS], (bf16_t*)(ws + WS_XB) + (size_t)MP * D, (size_t)MS * D / 4, 1, 0, 0, ws + WS_XB8 + (size_t)MP * D);
    }
    float* rope = (float*)(ws + WS_ROPE);
    for (int i = F.bid * NTHREADS + F.tid; i < 4096 * 24; i += F.G * NTHREADS) {
        const int pos = i / 24, k = i % 24; float inv, s, c;
        if (k < 16) { inv = powf(500000.0f, -(float)k / 16.0f); sincosf((float)pos * inv, &s, &c); rope[pos * 16 + k] = c; rope[4096 * 16 + pos * 16 + k] = s; }
        else { const int kk = k - 16; inv = powf(500000.0f, -(float)kk / 8.0f); sincosf((float)pos * inv, &s, &c); rope[4096 * 32 + pos * 8 + kk] = c; rope[4096 * 40 + pos * 8 + kk] = s; }
    }
}

__device__ __forceinline__ unsigned ord_key(unsigned u) { return (u & 0x80000000u) ? ~u : (u | 0x80000000u); }
__device__ __forceinline__ int wave_sum_i(int v) {
#pragma unroll
    for (int o = 1; o < 64; o <<= 1) v += shflx_i(v, o);
    return v;
}
__device__ __forceinline__ int wave_sum_i_dpp(int v) {
#define DPP_ADDI(ctrl, rmask) v += __builtin_amdgcn_update_dpp(0, v, ctrl, rmask, 0xF, false)
    DPP_ADDI(0xB1, 0xF); DPP_ADDI(0x4E, 0xF); DPP_ADDI(0x141, 0xF); DPP_ADDI(0x140, 0xF); DPP_ADDI(0x142, 0xA); DPP_ADDI(0x143, 0xC);
#undef DPP_ADDI
    return __builtin_amdgcn_readlane(v, 63);
}
constexpr int CW_SCD = 65536;
__device__ __forceinline__ int sel_uid(int samp, int b, int c) { return samp ? 128 + b : b * 64 + c; }
__device__ __forceinline__ int sel_nchunks(int samp, int c) { return samp ? 5 : ((c + 1 + 7) >> 3); }

__device__ __forceinline__ void score_item(const Frame& F, int l, int samp, int b, int c, int kc) {
    int tid = F.tid, lane = F.lane; const int wave = F.wave; asm volatile("" : "+v"(tid), "+v"(lane));
    __attribute__((address_space(1))) unsigned char* wsl_ = (__attribute__((address_space(1))) unsigned char*)F.ws; asm volatile("" : "+s"(wsl_)); unsigned char* ws = (unsigned char*)wsl_;
    const int r0 = samp ? MP + b * 64 : b * SEQ + c * 64;
    const int L = samp ? SKS : 64 * (c + 1);
    const int k0 = 512 * kc, k1 = (k0 + 512 < L) ? k0 + 512 : L;
    const bf16_t* KI = samp ? (const bf16_t*)(ws + WS_KIS) + (size_t)b * SKS * 64 : (const bf16_t*)(ws + WS_KIP) + (size_t)b * SEQ * 64;
    unsigned* SC = (unsigned*)(ws + WS_SC) + (size_t)r0 * 4096;
    const Args A = load_args(); const float* CKI = A.in[I_CKI] + (size_t)(l * DB + b) * PAST * 64;
    LAS unsigned char* QiL = F.lds;
    LAS float* WIl = (LAS float*)(F.lds + 66560);
    const bf16_t* QI = (const bf16_t*)(ws + WS_QI) + (size_t)r0 * 512;
    const int rl = lane & 31, h = lane >> 5;
    const int kbA = (k0 >> 5) + wave, kbB = kbA + NWAVES, nkb = (k1 >> 5);
    u32x4 raw[2][8];
#pragma unroll
    for (int u = 0; u < 2; ++u) { const int kb = u ? kbB : kbA; if (kb < nkb) { const int key = 32 * kb + rl;
        if (samp && key < PAST) { const float* kp = CKI + (size_t)key * 64 + 8 * h;
#pragma unroll
            for (int ks = 0; ks < 4; ++ks) { raw[u][2 * ks] = *(const u32x4*)(kp + 16 * ks); raw[u][2 * ks + 1] = *(const u32x4*)(kp + 16 * ks + 4); } }
        else {
#pragma unroll
            for (int ks = 0; ks < 4; ++ks) raw[u][ks] = *(const u32x4*)(KI + (size_t)key * 64 + 16 * ks + 8 * h); } } }
    { u32x4 st[8];
#pragma unroll
      for (int i = 0; i < 8; ++i) { const int id = tid + 512 * i, row = id >> 6, ch = id & 63; st[i] = *(const u32x4*)(QI + (size_t)row * 512 + ch * 8); }
      float wiv = ((const float*)(ws + WS_WI))[(size_t)r0 * 8 + tid];
      asm volatile("" : "+v"(st[0]), "+v"(st[1]), "+v"(st[2]), "+v"(st[3]), "+v"(st[4]), "+v"(st[5]), "+v"(st[6]), "+v"(st[7]), "+v"(wiv));
#pragma unroll
      for (int i = 0; i < 8; ++i) { const int id = tid + 512 * i, row = id >> 6, ch = id & 63; *(LAS u32x4*)(QiL + row * 1040 + ch * 16) = st[i]; }
      WIl[tid] = wiv; }
    __syncthreads();
#ifndef SCORE_REP
#define SCORE_REP 1
#endif
    for (int srep = 0; srep < SCORE_REP; ++srep)
#pragma unroll
    for (int u = 0; u < 2; ++u) { const int kb = u ? kbB : kbA; if (kb >= nkb) continue;
        const int key = 32 * kb + rl;
        bf16x8 bfr[4];
        if (samp && key < PAST) {
#pragma unroll
            for (int ks = 0; ks < 4; ++ks) { const u32x4 x0 = raw[u][2 * ks], x1 = raw[u][2 * ks + 1];
                union { bf16x8 v; unsigned w[4]; } u_; u_.w[0] = pk2(__uint_as_float(x0[0]), __uint_as_float(x0[1])); u_.w[1] = pk2(__uint_as_float(x0[2]), __uint_as_float(x0[3]));
                u_.w[2] = pk2(__uint_as_float(x1[0]), __uint_as_float(x1[1])); u_.w[3] = pk2(__uint_as_float(x1[2]), __uint_as_float(x1[3])); bfr[ks] = u_.v; }
        } else {
#pragma unroll
            for (int ks = 0; ks < 4; ++ks) { union { bf16x8 v; u32x4 w; } u_; u_.w = raw[u][ks]; bfr[ks] = u_.v; }
        }
#pragma unroll 1
        for (int qh = 0; qh < 2; ++qh) {
            f32x16 sc;
#pragma unroll
            for (int i = 0; i < 16; ++i) sc[i] = 0.f;
#pragma unroll 1
            for (int hh = 0; hh < 8; hh += 2) {
                f32x16 s0, s1;
#pragma unroll
                for (int i = 0; i < 16; ++i) { s0[i] = 0.f; s1[i] = 0.f; }
#pragma unroll
                for (int ks = 0; ks < 4; ++ks) { const LAS unsigned char* ap = QiL + (32 * qh + rl) * 1040 + (hh * 64 + 16 * ks + 8 * h) * 2;
                    const bf16x8 a0 = *(const LAS bf16x8*)(ap), a1 = *(const LAS bf16x8*)(ap + 128);
                    s0 = __builtin_amdgcn_mfma_f32_32x32x16_bf16(a0, bfr[ks], s0, 0, 0, 0); s1 = __builtin_amdgcn_mfma_f32_32x32x16_bf16(a1, bfr[ks], s1, 0, 0, 0); }
#pragma unroll
                for (int i = 0; i < 16; ++i) { const int q = 32 * qh + (i & 3) + 8 * (i >> 2) + 4 * h; const f32x2 w2 = *(const LAS f32x2*)(WIl + q * 8 + hh); sc[i] += w2[0] * fmaxf(s0[i], 0.f) + w2[1] * fmaxf(s1[i], 0.f); }
            }
#pragma unroll
            for (int i = 0; i < 16; ++i) { const int q = 32 * qh + (i & 3) + 8 * (i >> 2) + 4 * h; __hip_atomic_store(SC + (size_t)q * 4096 + key, __float_as_uint(sc[i]), __ATOMIC_RELAXED, __HIP_MEMORY_SCOPE_AGENT); }
        }
    }
    asm volatile("s_waitcnt vmcnt(0)" ::: "memory");
    __syncthreads();
    if (tid == 0) __hip_atomic_fetch_add(F.ctl + CW_SCD + 16 * (l * 160 + sel_uid(samp, b, c)), 1u, __ATOMIC_RELAXED, __HIP_MEMORY_SCOPE_AGENT);
}

#define SEL_FINISH(key, prefix, exact, myw) do { \
        asm volatile("" : "+v"(prefix));        \
        if (exact) { \
            _Pragma("unroll") for (int j = 0; j < 64; ++j) { const u64 ge = __ballot(key[j] >= prefix); if (lane == j) myw = ge; } \
        } else {        \
            int cgt = 0; \
            _Pragma("unroll") for (int j = 0; j < 64; ++j) cgt += (key[j] > prefix) ? 1 : 0; \
            cgt = wave_sum_i_dpp(cgt); \
            int rem = 256 - cgt; \
            _Pragma("unroll 1") for (int j = 0; j < 64; ++j) { \
                unsigned kj = 0u; \
                _Pragma("unroll") for (int jj = 0; jj < 64; ++jj) kj = (jj == j) ? key[jj] : kj; \
                const u64 gt = __ballot(kj > prefix), eq = __ballot(kj == prefix); \
                u64 take = 0ull; \
                if (eq != 0ull && rem > 0) { const int pc = __popcll(eq); if (pc <= rem) { take = eq; rem -= pc; } else { u64 t = eq; for (int z = 0; z < rem; ++z) t &= t - 1ull; take = eq ^ t; rem = 0; } } \
                if (lane == j) myw = gt | take; } } } while (0)
__device__ __forceinline__ void select_item(const Frame& F, int l, int samp, int b, int c, int qg) {
    int tid = F.tid, lane = F.lane; const int wave = F.wave; asm volatile("" : "+v"(tid), "+v"(lane));
    __attribute__((address_space(1))) unsigned char* wsl_ = (__attribute__((address_space(1))) unsigned char*)F.ws; asm volatile("" : "+s"(wsl_)); unsigned char* ws = (unsigned char*)wsl_;
    const int r0 = samp ? MP + b * 64 : b * SEQ + c * 64;
    const int L = samp ? SKS : 64 * (c + 1);
    const int nj = L >> 6;
    u64* SEL = (u64*)(ws + WS_SEL) + (size_t)r0 * 64;
    const int qA = qg * 16 + wave * 2, qB = qA + 1;
    u64 mywA = 0ull, mywB = 0ull;
    if (L <= 256) { mywA = (lane < nj) ? ~0ull : 0ull; mywB = mywA; }
    else {
        {
            unsigned* cw = F.ctl + CW_SCD + 16 * (l * 160 + sel_uid(samp, b, c)); const unsigned need = (unsigned)sel_nchunks(samp, c);
            unsigned spins = 0;
            while ((unsigned)__builtin_amdgcn_readfirstlane((int)__hip_atomic_load(cw, __ATOMIC_RELAXED, __HIP_MEMORY_SCOPE_AGENT)) < need) { __builtin_amdgcn_s_sleep(2); if (++spins > (1u << 22)) break; }
            __builtin_amdgcn_fence(__ATOMIC_ACQUIRE, "agent");
        }
        unsigned keyA[64], keyB[64];
        typedef __attribute__((address_space(1))) unsigned gu32_t;
        gu32_t* rowA = (gu32_t*)((unsigned*)(ws + WS_SC) + (size_t)(r0 + qA) * 4096) + lane; gu32_t* rowB = rowA + 4096;
#pragma unroll
        for (int j = 0; j < 64; ++j) { keyA[j] = rowA[64 * j]; keyB[j] = rowB[64 * j]; }
#pragma unroll
        for (int j = 0; j < 64; ++j) { keyA[j] = (j < nj) ? ord_key(keyA[j]) : 0x007FFFFFu; keyB[j] = (j < nj) ? ord_key(keyB[j]) : 0x007FFFFFu; }
        unsigned prefixA = 0u, prefixB = 0u; bool doneA = false, doneB = false;
        for (int bit = 31; bit >= 0 && !(doneA && doneB); --bit) {
            const unsigned candA = prefixA | (1u << bit), candB = prefixB | (1u << bit), cA1 = candA - 1u, cB1 = candB - 1u; unsigned a4[4] = {0u, 0u, 0u, 0u}, b4[4] = {0u, 0u, 0u, 0u};
#pragma unroll
            for (int j = 0; j < 64; ++j) { a4[j & 3] += min(__builtin_elementwise_sub_sat(keyA[j], cA1), 1u); b4[j & 3] += min(__builtin_elementwise_sub_sat(keyB[j], cB1), 1u); }
            const int cntA = wave_sum_i_dpp((int)((a4[0] + a4[1]) + (a4[2] + a4[3]))), cntB = wave_sum_i_dpp((int)((b4[0] + b4[1]) + (b4[2] + b4[3])));
            if (!doneA) { if (cntA >= 256) prefixA = candA; if (cntA == 256) doneA = true; }
            if (!doneB) { if (cntB >= 256) prefixB = candB; if (cntB == 256) doneB = true; }
        }
        SEL_FINISH(keyA, prefixA, doneA, mywA);
        SEL_FINISH(keyB, prefixB, doneB, mywB);
    }
    SEL[(size_t)qA * 64 + lane] = mywA; SEL[(size_t)qB * 64 + lane] = mywB;
}
#undef SEL_FINISH

__device__ __forceinline__ void attn_unit(const Frame& F, int l, int samp, int b, int c, int g) {
    const Args A = load_args();
    int tid = F.tid, lane = F.lane; const int wave = F.wave; asm volatile("" : "+v"(tid), "+v"(lane));
    __attribute__((address_space(1))) unsigned char* wsl_ = (__attribute__((address_space(1))) unsigned char*)F.ws; asm volatile("" : "+s"(wsl_)); unsigned char* ws = (unsigned char*)wsl_;
    const int r0 = samp ? MP + b * 64 : b * SEQ + c * 64;
    const int L = samp ? SKS : 64 * (c + 1), ntiles = L >> 6;
    const bf16_t* Kb = samp ? (const bf16_t*)(ws + WS_KS) + (size_t)b * SKS * 256 + g * 128 : (const bf16_t*)(ws + WS_KP) + (size_t)b * SEQ * 256 + g * 128;
    const bf16_t* Vb = samp ? (const bf16_t*)(ws + WS_VS) + (size_t)b * SKS * 256 + g * 128 : (const bf16_t*)(ws + WS_VP) + (size_t)b * SEQ * 256 + g * 128;
    const int hh = wave >> 1, qb = wave & 1, rl = lane & 31, h = lane >> 5, qrow = 32 * qb + rl, head = 4 * g + hh;
    const u64* SELr = (const u64*)(ws + WS_SEL) + (size_t)(r0 + qrow) * 64;
    bf16x8 qf[8];
    { const bf16_t* Qp = (const bf16_t*)(ws + WS_Q) + (size_t)(r0 + qrow) * WL + head * 128 + 8 * h;
#pragma unroll
      for (int ks = 0; ks < 8; ++ks) qf[ks] = *(const bf16x8*)(Qp + 16 * ks); }
    LAS unsigned char* KT = F.lds;
    LAS unsigned char* VT = F.lds + 34816;
    f32x16 o[4];
#pragma unroll
    for (int d = 0; d < 4; ++d)
#pragma unroll
        for (int i = 0; i < 16; ++i) o[d][i] = 0.f;
    float mrun = -INFINITY, lsum = 0.f;
    const float* CKf = A.in[I_CK] + ((size_t)(l * DB + b) * PAST) * 256 + g * 128; const float* CVf = A.in[I_CV] + ((size_t)(l * DB + b) * PAST) * 256 + g * 128;
    u32x4 kr[4], vr[4]; u64 mwn = 0ull, mwc;
    const int vp = tid & 31, vch = tid >> 5;
#define ATT_F32(t) (samp && (t) < (PAST >> 6))
#define ATT_LOAD(t) do { if (ATT_F32(t)) { \
            _Pragma("unroll") for (int i = 0; i < 2; ++i) { const int cid = tid + 512 * i; const float* p_ = CKf + (size_t)(64 * (t) + (cid >> 4)) * 256 + (cid & 15) * 8; kr[2 * i] = *(const u32x4*)(p_); kr[2 * i + 1] = *(const u32x4*)(p_ + 4); } \
            { const float* p_ = CVf + (size_t)(64 * (t) + 2 * vp) * 256 + vch * 8; vr[0] = *(const u32x4*)(p_); vr[1] = *(const u32x4*)(p_ + 4); vr[2] = *(const u32x4*)(p_ + 256); vr[3] = *(const u32x4*)(p_ + 260); } \
        } else { \
            _Pragma("unroll") for (int i = 0; i < 2; ++i) { const int cid = tid + 512 * i; kr[i] = *(const u32x4*)(Kb + (size_t)(64 * (t) + (cid >> 4)) * 256 + (cid & 15) * 8); } \
            vr[0] = *(const u32x4*)(Vb + (size_t)(64 * (t) + 2 * vp) * 256 + vch * 8); vr[1] = *(const u32x4*)(Vb + (size_t)(64 * (t) + 2 * vp + 1) * 256 + vch * 8); } \
        mwn = SELr[(t)]; } while (0)
#define ATT_PK(x_, y_) (u32x4){pk2(__uint_as_float((x_)[0]), __uint_as_float((x_)[1])), pk2(__uint_as_float((x_)[2]), __uint_as_float((x_)[3])), pk2(__uint_as_float((y_)[0]), __uint_as_float((y_)[1])), pk2(__uint_as_float((y_)[2]), __uint_as_float((y_)[3]))}
#define ATT_WRITE(buf, t) do { u32x4 k0_, k1_, va_, vb_; \
        if (ATT_F32(t)) { k0_ = ATT_PK(kr[0], kr[1]); k1_ = ATT_PK(kr[2], kr[3]); va_ = ATT_PK(vr[0], vr[1]); vb_ = ATT_PK(vr[2], vr[3]); } else { k0_ = kr[0]; k1_ = kr[1]; va_ = vr[0]; vb_ = vr[1]; } \
        *(LAS u32x4*)(KT + (buf) * 17408 + (tid >> 4) * 272 + (tid & 15) * 16) = k0_; *(LAS u32x4*)(KT + (buf) * 17408 + ((tid + 512) >> 4) * 272 + (tid & 15) * 16) = k1_; \
        _Pragma("unroll") for (int i = 0; i < 4; ++i) { const unsigned a = va_[i], bb = vb_[i]; \
            *(LAS unsigned*)(VT + (buf) * 17408 + (8 * vch + 2 * i) * 136 + vp * 4) = (a & 0xffffu) | (bb << 16); \
            *(LAS unsigned*)(VT + (buf) * 17408 + (8 * vch + 2 * i + 1) * 136 + vp * 4) = (a >> 16) | (bb & 0xffff0000u); } } while (0)
#define ATT_PIN8(a_) asm volatile("" : "+v"((a_)[0]), "+v"((a_)[1]), "+v"((a_)[2]), "+v"((a_)[3]), "+v"((a_)[4]), "+v"((a_)[5]), "+v"((a_)[6]), "+v"((a_)[7]))
#define ATT_PIN4(a_) asm volatile("" : "+v"((a_)[0]), "+v"((a_)[1]), "+v"((a_)[2]), "+v"((a_)[3]))
#define ATT_RDV(dst_, g_) do { _Pragma("unroll") for (int d = 0; d < 4; ++d) { union { bf16x8 v; u32x2 w[2]; } vf_; \
            const LAS unsigned char* vrow = VT + buf_ * 17408 + (32 * d + rl) * 136 + (32 * ((g_) >> 1) + 16 * ((g_) & 1) + 4 * h) * 2; \
            vf_.w[0] = *(const LAS u32x2*)(vrow); vf_.w[1] = *(const LAS u32x2*)(vrow + 16); (dst_)[d] = vf_.v; } } while (0)
#define ATT_COMPUTE(buf, mw) do { \
        const int buf_ = (buf); \
        f32x16 s[2]; \
        _Pragma("unroll") \
        for (int kh = 0; kh < 2; ++kh) \
        _Pragma("unroll") \
            for (int i = 0; i < 16; ++i) s[kh][i] = 0.f; \
        { bf16x8 ka0[8], ka1[8]; \
          _Pragma("unroll") for (int ks = 0; ks < 8; ++ks) ka0[ks] = *(const LAS bf16x8*)(KT + buf_ * 17408 + (rl) * 272 + (16 * ks + 8 * h) * 2); \
          ATT_PIN8(ka0); \
          _Pragma("unroll") for (int ks = 0; ks < 8; ++ks) ka1[ks] = *(const LAS bf16x8*)(KT + buf_ * 17408 + (32 + rl) * 272 + (16 * ks + 8 * h) * 2); \
          _Pragma("unroll") for (int ks = 0; ks < 8; ++ks) s[0] = __builtin_amdgcn_mfma_f32_32x32x16_bf16(ka0[ks], qf[ks], s[0], 0, 0, 0); \
          ATT_PIN8(ka1); \
          _Pragma("unroll") for (int ks = 0; ks < 8; ++ks) s[1] = __builtin_amdgcn_mfma_f32_32x32x16_bf16(ka1[ks], qf[ks], s[1], 0, 0, 0); } \
        bf16x8 vfa[4], vfb[4]; \
        ATT_RDV(vfa, 0); \
        const u64 mws = mw >> (4 * h); \
        const unsigned mlo = (unsigned)mws, mhi = (unsigned)(mws >> 32); \
        float mx = -INFINITY; \
        _Pragma("unroll") \
        for (int kh = 0; kh < 2; ++kh) \
        _Pragma("unroll") \
            for (int i = 0; i < 16; ++i) { const unsigned wv = kh ? mhi : mlo; const bool ok = (wv >> ((i & 3) + 8 * (i >> 2))) & 1u; s[kh][i] = ok ? s[kh][i] : -INFINITY; mx = fmaxf(mx, s[kh][i]); } \
        mx = fmaxf(mx, shflx(mx, 32)); \
        const float mnew = fmaxf(mrun, mx), muse = (mnew == -INFINITY) ? 0.f : mnew; \
        const float alpha = __builtin_amdgcn_exp2f(mrun - muse); \
        mrun = mnew; \
        float psum = 0.f; \
        _Pragma("unroll") \
        for (int kh = 0; kh < 2; ++kh) \
        _Pragma("unroll") \
            for (int i = 0; i < 16; ++i) { s[kh][i] = __builtin_amdgcn_exp2f(s[kh][i] - muse); psum += s[kh][i]; } \
        lsum = lsum * alpha + psum; \
        _Pragma("unroll") \
        for (int d = 0; d < 4; ++d) \
        _Pragma("unroll") \
            for (int i = 0; i < 16; ++i) o[d][i] *= alpha; \
        _Pragma("unroll") \
        for (int g_ = 0; g_ < 4; ++g_) { const int kh = g_ >> 1, sp = g_ & 1; \
            union { bf16x8 v; unsigned w[4]; } pf; \
            _Pragma("unroll") \
            for (int j = 0; j < 4; ++j) pf.w[j] = pk2(s[kh][8 * sp + 2 * j], s[kh][8 * sp + 2 * j + 1]); \
            if ((g_ & 1) == 0) { ATT_RDV(vfb, g_ + 1); ATT_PIN4(vfa); \
                _Pragma("unroll") for (int d = 0; d < 4; ++d) o[d] = __builtin_amdgcn_mfma_f32_32x32x16_bf16(vfa[d], pf.v, o[d], 0, 0, 0); } \
            else { if (g_ + 1 < 4) ATT_RDV(vfa, g_ + 1); ATT_PIN4(vfb); \
                _Pragma("unroll") for (int d = 0; d < 4; ++d) o[d] = __builtin_amdgcn_mfma_f32_32x32x16_bf16(vfb[d], pf.v, o[d], 0, 0, 0); } \
        } \
    } while (0)
    ATT_LOAD(0);
    ATT_WRITE(0, 0); mwc = mwn;
    __syncthreads();
    for (int t = 0; t < ntiles; ++t) {
        const int buf = t & 1;
        if (t + 1 < ntiles) ATT_LOAD(t + 1);
        ATT_COMPUTE(buf, mwc);
        if (t + 1 < ntiles) ATT_WRITE(buf ^ 1, t + 1);
        mwc = mwn; asm volatile("" : "+v"(mwc));
        __syncthreads();
    }
#undef ATT_COMPUTE
#undef ATT_RDV
#undef ATT_PIN4
#undef ATT_PIN8
#undef ATT_LOAD
#undef ATT_WRITE
#undef ATT_PK
#undef ATT_F32
    const float ltot = lsum + shflx(lsum, 32), inv = 1.0f / ltot;
    unsigned char* YC = ws + WS_Y + (size_t)2 * M * WL + (size_t)(r0 + qrow) * WL + head * 128;
#pragma unroll
    for (int d = 0; d < 4; ++d)
#pragma unroll
        for (int ig = 0; ig < 4; ++ig) *(unsigned*)(YC + 32 * d + 8 * ig + 4 * h) = pk4_fp8((f32x4){o[d][4 * ig] * inv, o[d][4 * ig + 1] * inv, o[d][4 * ig + 2] * inv, o[d][4 * ig + 3] * inv});
}
template <bool YPH>
__device__ __forceinline__ void lru_pair(const Frame& F, int l, int samp, int b, int c, int n0) {
    const Args A = load_args();
    int tid = F.tid, lane = F.lane; const int wave = F.wave; asm volatile("" : "+v"(tid), "+v"(lane));
    __attribute__((address_space(1))) unsigned char* wsl_ = (__attribute__((address_space(1))) unsigned char*)F.ws; asm volatile("" : "+s"(wsl_)); unsigned char* ws = (unsigned char*)wsl_;
    const int r0 = samp ? MP + b * 64 : b * SEQ + c * 64;
    const int grp = wave >> 2, w4 = wave & 3, n = n0 + grp;
    LAS unsigned char* lb = F.lds + grp * 47616;
    LAS unsigned char* XCb = lb;
    LAS float* Rl = (LAS float*)(lb + 9216);
    LAS float* Il = (LAS float*)(lb + 25856);
    LAS float* CP = (LAS float*)(lb + 42496);
    const int ch = tid & 63, tq = (tid >> 6) & 3, cg = n * 64 + ch;
    const int gate = w4 >> 1, r16 = lane & 15, hq = lane >> 4;
    bf16x8 bw[4][2]; float bv[4];
    { const bf16_t* LW = (const bf16_t*)(ws + WS_LRUW) + (size_t)((l * 2 + gate) * 16 + n) * 4096; const float* bias = A.in[gate ? I_LBI : I_LBR] + l * WL + n * 64;
#pragma unroll
      for (int nt = 0; nt < 4; ++nt) { bv[nt] = bias[16 * nt + r16];
#pragma unroll
          for (int ks = 0; ks < 2; ++ks) bw[nt][ks] = *(const bf16x8*)(LW + (16 * nt + r16) * 64 + 32 * ks + 8 * hq); } }
    const float lam = A.in[I_LAM][l * WL + cg];
    float* CH = (float*)(ws + WS_CH);
    f32x2 ph[16]; unsigned short gzr[16]; float h0s = 0.f;
    if (YPH) {
        const bf16_t* GZ = (const bf16_t*)(ws + WS_GZ);
#pragma unroll
        for (int k = 0; k < 16; ++k) gzr[k] = GZ[(size_t)(r0 + 16 * tq + k) * WL + cg];
        if (!samp) {
#pragma unroll
            for (int k = 0; k < 16; ++k) { const int cc = 16 * w4 + k; ph[k] = (f32x2){1.f, 0.f}; if (cc < c) ph[k] = *(const f32x2*)(CH + ((size_t)(b * 64 + cc) * WL + n * 64 + lane) * 2); }
        } else h0s = A.in[I_SH][(size_t)(l * DB + b) * WL + n * 64 + lane];
    }
    float xc[16];
    {
        const bf16_t* ZA = (const bf16_t*)(ws + WS_ZA);
        float zl[19]; unsigned zraw[19];
#pragma unroll
        for (int k = 0; k < 19; ++k) { const int tt = 16 * tq - 3 + k; unsigned v;
            if (tt >= 0 || c > 0) v = (unsigned)ZA[(size_t)(r0 + tt) * WL + cg];
            else v = samp ? __float_as_uint(A.in[I_SLC][((size_t)(l * DB + b) * 3 + (3 + tt)) * WL + cg]) : 0u;
            zraw[k] = v; }
        float cw[4];
#pragma unroll
        for (int j = 0; j < 4; ++j) cw[j] = A.in[I_LCW][(size_t)(l * 4 + j) * WL + cg];
        const float cb = A.in[I_LCB][l * WL + cg];
        asm volatile("" : "+v"(zraw[0]), "+v"(zraw[1]), "+v"(zraw[2]), "+v"(zraw[3]), "+v"(zraw[4]), "+v"(zraw[5]), "+v"(zraw[6]), "+v"(zraw[7]), "+v"(zraw[8]), "+v"(zraw[9]),
                     "+v"(zraw[10]), "+v"(zraw[11]), "+v"(zraw[12]), "+v"(zraw[13]), "+v"(zraw[14]), "+v"(zraw[15]), "+v"(zraw[16]), "+v"(zraw[17]), "+v"(zraw[18]));
#pragma unroll
        for (int k = 0; k < 19; ++k) { const int tt = 16 * tq - 3 + k; zl[k] = (tt >= 0 || c > 0) ? bf2f(zraw[k]) : __uint_as_float(zraw[k]); }
#pragma unroll
        for (int k = 0; k < 16; ++k) { xc[k] = cb + cw[0] * zl[k] + cw[1] * zl[k + 1] + cw[2] * zl[k + 2] + cw[3] * zl[k + 3];
            *(LAS bf16_t*)(XCb + (16 * tq + k) * 144 + ch * 2) = (bf16_t)f2bf(xc[k]); }
    }
    __syncthreads();
    {
        LAS float* dst = gate ? Il : Rl;
#pragma unroll
        for (int mm = 0; mm < 2; ++mm) { const int mt = 2 * (w4 & 1) + mm;
            bf16x8 a[2];
#pragma unroll
            for (int ks = 0; ks < 2; ++ks) a[ks] = *(const LAS bf16x8*)(XCb + (16 * mt + r16) * 144 + (32 * ks + 8 * hq) * 2);
#pragma unroll
            for (int nt = 0; nt < 4; ++nt) { f32x4 acc = (f32x4){0.f, 0.f, 0.f, 0.f};
#pragma unroll
                for (int ks = 0; ks < 2; ++ks) acc = __builtin_amdgcn_mfma_f32_16x16x32_bf16(a[ks], bw[nt][ks], acc, 0, 0, 0);
#pragma unroll
                for (int rg = 0; rg < 4; ++rg) dst[(16 * mt + 4 * hq + rg) * 65 + 16 * nt + r16] = sigmoidf_(acc[rg] + bv[nt]); } }
    }
    __syncthreads();
    float av[16], uv[16];
    {
        const float sp = log1pf(__expf(-lam));
        float rr_[16], ig_[16];
#pragma unroll
        for (int k = 0; k < 16; ++k) { const int t = 16 * tq + k; rr_[k] = Rl[t * 65 + ch]; ig_[k] = Il[t * 65 + ch]; }
        asm volatile("" : "+v"(rr_[0]), "+v"(rr_[1]), "+v"(rr_[2]), "+v"(rr_[3]), "+v"(rr_[4]), "+v"(rr_[5]), "+v"(rr_[6]), "+v"(rr_[7]), "+v"(rr_[8]), "+v"(rr_[9]), "+v"(rr_[10]), "+v"(rr_[11]), "+v"(rr_[12]), "+v"(rr_[13]), "+v"(rr_[14]), "+v"(rr_[15]) :: "memory");
        asm volatile("" : "+v"(ig_[0]), "+v"(ig_[1]), "+v"(ig_[2]), "+v"(ig_[3]), "+v"(ig_[4]), "+v"(ig_[5]), "+v"(ig_[6]), "+v"(ig_[7]), "+v"(ig_[8]), "+v"(ig_[9]), "+v"(ig_[10]), "+v"(ig_[11]), "+v"(ig_[12]), "+v"(ig_[13]), "+v"(ig_[14]), "+v"(ig_[15]) :: "memory");
#pragma unroll
        for (int k = 0; k < 16; ++k) { const float la = -8.0f * rr_[k] * sp; av[k] = __expf(la); uv[k] = sqrtf(fmaxf(1.0f - av[k] * av[k], 0.f)) * ig_[k] * xc[k]; }
    }
    if (YPH && !samp) {
        float P = 1.f, H = 0.f;
#pragma unroll
        for (int k = 0; k < 16; ++k) { H = ph[k].x * H + ph[k].y; P = P * ph[k].x; }
        CP[(w4 * 64 + lane) * 2] = P; CP[(w4 * 64 + lane) * 2 + 1] = H;
    }
    {
        LAS float* CP2 = (LAS float*)(lb + 44544);
        const int cgl = n * 64 + lane;
        float Pw = 1.f, Hw = 0.f;
#pragma unroll
        for (int k = 0; k < 16; ++k) { Hw = av[k] * Hw + uv[k]; Pw *= av[k]; }
        CP2[(w4 * 64 + lane) * 2] = Pw; CP2[(w4 * 64 + lane) * 2 + 1] = Hw;
        __syncthreads();
        float hst = 0.f;
        if (YPH) { if (samp) hst = h0s; else {
#pragma unroll
            for (int w = 0; w < 4; ++w) hst = CP[(w * 64 + lane) * 2] * hst + CP[(w * 64 + lane) * 2 + 1]; } }
        if (!YPH) {
            if (w4 == 0) { float P = 1.f;
#pragma unroll
                for (int w = 0; w < 4; ++w) { hst = CP2[(w * 64 + lane) * 2] * hst + CP2[(w * 64 + lane) * 2 + 1]; P *= CP2[(w * 64 + lane) * 2]; }
                *(f32x2*)(CH + ((size_t)(b * 64 + c) * WL + cgl) * 2) = (f32x2){P, hst}; }
        } else {
#pragma unroll
            for (int w = 0; w < 3; ++w) if (w < w4) hst = CP2[(w * 64 + lane) * 2] * hst + CP2[(w * 64 + lane) * 2 + 1];
            unsigned char* YA = ws + WS_Y;
#pragma unroll
            for (int k = 0; k < 16; ++k) { const int t = 16 * tq + k; hst = av[k] * hst + uv[k];
                const float yv = hst * bf2f(gzr[k]); YA[(size_t)(r0 + t) * WL + cg] = (unsigned char)(__builtin_amdgcn_cvt_pk_fp8_f32(yv, yv, 0, false) & 0xff); }
            if (w4 == 3) { if (samp) A.out[O_HS + (size_t)(l * DB + b) * WL + cgl] = hst; else if (c == 63) A.out[O_HP + (size_t)(l * 2 + b) * WL + cgl] = hst; }
        }
    }
    __syncthreads();
}

__device__ __forceinline__ void conf_unit(const Frame& F, int l, int unit) {
    const Args A = load_args();
    int tid = F.tid, lane = F.lane; const int wave = F.wave; asm volatile("" : "+v"(tid), "+v"(lane));
    __attribute__((address_space(1))) unsigned char* wsl_ = (__attribute__((address_space(1))) unsigned char*)F.ws; asm volatile("" : "+s"(wsl_)); unsigned char* ws = (unsigned char*)wsl_;
    const int r0 = unit * 32; const RowI ri = rowinfo(r0); const bool samp = r0 >= MP; const int t0 = ri.t;
    int tid2 = 2 * tid; asm volatile("" : "+v"(tid2));
    const bf16_t* GLU = (const bf16_t*)(ws + WS_GLU);
    const float* cwp = A.in[I_CCW] + (size_t)l * 31 * WL + tid2;
    f32x2 w[31];
#pragma unroll
    for (int j = 0; j < 31; ++j) w[j] = *(const f32x2*)(cwp + (size_t)j * WL);
    const f32x2 bias = *(const f32x2*)(A.in[I_CCB] + l * WL + tid2);
    f32x2 acc[32];
#pragma unroll
    for (int t = 0; t < 32; ++t) acc[t] = bias;
#pragma unroll
    for (int sg = 0; sg < 64; sg += 16) {
        f32x2 xg[16];
#pragma unroll
        for (int k = 0; k < 16; ++k) { const int s = sg + k; if (s < 62) {
            const int tg = t0 - 30 + s; f32x2 x;
            if (tg >= 0) { const unsigned u = *(const unsigned*)(GLU + (size_t)(r0 - 30 + s) * WL + tid2); x = (f32x2){bflo(u), bfhi(u)}; }
            else if (samp) x = *(const f32x2*)(A.in[I_SCC] + ((size_t)(l * DB + ri.b) * 30 + (30 + tg)) * WL + tid2);
            else x = (f32x2){0.f, 0.f};
            xg[k] = x; } }
#pragma unroll
        for (int k = 0; k < 16; ++k) { const int s = sg + k; if (s < 62) {
#pragma unroll
            for (int j = 0; j < 31; ++j) { const int t = s - j; if (t >= 0 && t < 32) acc[t] += w[j] * xg[k]; } } }
        asm volatile("" ::: "memory");
    }
    LAS float* CB = (LAS float*)F.lds;
#pragma unroll
    for (int t = 0; t < 32; ++t) *(LAS f32x2*)(CB + t * 1024 + tid2) = acc[t];
    __syncthreads();
    const float* lg = A.in[I_CLG] + l * WL; const float* lb = A.in[I_CLB] + l * WL; unsigned char* YB = ws + WS_Y + (size_t)M * WL;
    f32x4 lgv[4], lbv[4];
#pragma unroll
    for (int j = 0; j < 4; ++j) { lgv[j] = *(const f32x4*)(lg + 256 * j + 4 * lane); lbv[j] = *(const f32x4*)(lb + 256 * j + 4 * lane); }
#pragma unroll
    for (int k = 0; k < 4; ++k) { const int t = 4 * wave + k; f32x4 v[4]; float s = 0.f;
#pragma unroll
        for (int j = 0; j < 4; ++j) { v[j] = *(const LAS f32x4*)(CB + t * 1024 + 256 * j + 4 * lane); s += (v[j][0] + v[j][1]) + (v[j][2] + v[j][3]); }
        const float mean = wave_sum(s) * (1.0f / 1024.0f); float q = 0.f;
#pragma unroll
        for (int j = 0; j < 4; ++j) { v[j] = v[j] - mean; q += (v[j][0] * v[j][0] + v[j][1] * v[j][1]) + (v[j][2] * v[j][2] + v[j][3] * v[j][3]); }
        const float rstd = 1.0f / sqrtf(wave_sum(q) * (1.0f / 1024.0f) + LN_EPS);
#pragma unroll
        for (int j = 0; j < 4; ++j) { const int cix = 256 * j + 4 * lane; const f32x4 gg = lgv[j], bb = lbv[j]; f32x4 y = v[j] * rstd * gg + bb;
#pragma unroll
            for (int e = 0; e < 4; ++e) y[e] = y[e] * sigmoidf_(y[e]);
            *(unsigned*)(YB + (size_t)(r0 + t) * WL + cix) = pk4_fp8(y); } }
    __syncthreads();
}

template <int W>
__device__ __forceinline__ void pool_rows(const bf16_t* ZP, bf16_t* DF, const float* st, int r0, int t0, bool samp, int tid) {
    f32x2 x[64 + W - 1];
#pragma unroll
    for (int k = 0; k < 64 + W - 1; ++k) { const int rel = k - (W - 1), tg = t0 + rel;
        if (tg >= 0) { const unsigned u = *(const unsigned*)(ZP + (size_t)(r0 + rel) * WL + 2 * tid); x[k] = (f32x2){bflo(u), bfhi(u)}; }
        else if (samp) x[k] = *(const f32x2*)(st + (size_t)(15 + tg) * WL);
        else x[k] = (f32x2){0.f, 0.f}; }
    f32x2 rs = (f32x2){0.f, 0.f};
#pragma unroll
    for (int k = 0; k < W - 1; ++k) rs += x[k];
#pragma unroll
    for (int t = 0; t < 64; ++t) { rs += x[t + W - 1]; const f32x2 df = rs * (1.0f / W) - x[t + W - 1];
        *(unsigned*)(DF + (size_t)(r0 + t) * WL + 2 * tid) = pk2(df[0], df[1]);
        rs -= x[t]; }
}
__device__ __forceinline__ void pool_unit(const Frame& F, int l, int unit) {
    const Args A = load_args();
    int tid = F.tid; asm volatile("" : "+v"(tid));
    __attribute__((address_space(1))) unsigned char* wsl_ = (__attribute__((address_space(1))) unsigned char*)F.ws; asm volatile("" : "+s"(wsl_)); unsigned char* ws = (unsigned char*)wsl_;
    const int r0 = unit * 64; const RowI ri = rowinfo(r0); const bool samp = r0 >= MP; const int t0 = ri.t;
    const bf16_t* ZP = (const bf16_t*)(ws + WS_ZP); bf16_t* DF = (bf16_t*)(ws + WS_DIFF);
    const float* st = A.in[I_SPL] + (size_t)(l * DB + ri.b) * 15 * WL + 2 * tid;
    const int grp = tid >> 7;
    if (grp == 0) pool_rows<2>(ZP, DF, st, r0, t0, samp, tid);
    else if (grp == 1) pool_rows<4>(ZP, DF, st, r0, t0, samp, tid);
    else if (grp == 2) pool_rows<8>(ZP, DF, st, r0, t0, samp, tid);
    else pool_rows<16>(ZP, DF, st, r0, t0, samp, tid);
}

__device__ __forceinline__ void peer_score_unit(const Frame& F, int l, int unit) {
    int tid = F.tid, lane = F.lane; const int wave = F.wave; asm volatile("" : "+v"(tid), "+v"(lane));
    __attribute__((address_space(1))) unsigned char* wsl_ = (__attribute__((address_space(1))) unsigned char*)F.ws; asm volatile("" : "+s"(wsl_)); unsigned char* ws = (unsigned char*)wsl_;
    const int tt = unit >> 3, hd = unit & 7, r0 = tt * 64;
    LAS float* S = (LAS float*)F.lds;
    LAS float* SV = (LAS float*)(F.lds + 66048);
    LAS int* SI = (LAS int*)(F.lds + 66048 + 8192);
#ifndef P9_REP_A
#define P9_REP_A 1
#endif
#ifndef P9_REP_B
#define P9_REP_B 1
#endif
#ifndef P9_REP_C
#define P9_REP_C 1
#endif
    for (int repa = 0; repa < P9_REP_A; ++repa) {
        const int cc = wave >> 2, nb = wave & 3, rl = lane & 31, h = lane >> 5;
        const bf16_t* SK = (const bf16_t*)(ws + WS_SK) + ((size_t)((l * 8 + hd) * 2 + cc) * 128 + 32 * nb + rl) * 128 + 8 * h;
        bf16x8 bfr[8];
#pragma unroll
        for (int ks = 0; ks < 8; ++ks) bfr[ks] = *(const bf16x8*)(SK + 16 * ks);
        bf16x8 afr[2][8];
#pragma unroll
        for (int tb = 0; tb < 2; ++tb) { const bf16_t* QP = (const bf16_t*)(ws + WS_QP) + (size_t)(r0 + 32 * tb + rl) * D + hd * 256 + cc * 128 + 8 * h;
#pragma unroll
            for (int ks = 0; ks < 8; ++ks) afr[tb][ks] = *(const bf16x8*)(QP + 16 * ks); }
        asm volatile("" : "+v"(afr[0][0]), "+v"(afr[0][1]), "+v"(afr[0][2]), "+v"(afr[0][3]), "+v"(afr[0][4]), "+v"(afr[0][5]), "+v"(afr[0][6]), "+v"(afr[0][7]),
                     "+v"(afr[1][0]), "+v"(afr[1][1]), "+v"(afr[1][2]), "+v"(afr[1][3]), "+v"(afr[1][4]), "+v"(afr[1][5]), "+v"(afr[1][6]), "+v"(afr[1][7]));
#pragma unroll
        for (int tb = 0; tb < 2; ++tb) {
            f32x16 acc;
#pragma unroll
            for (int i = 0; i < 16; ++i) acc[i] = 0.f;
#pragma unroll
            for (int ks = 0; ks < 8; ++ks) acc = __builtin_amdgcn_mfma_f32_32x32x16_bf16(afr[tb][ks], bfr[ks], acc, 0, 0, 0);
#pragma unroll
            for (int i = 0; i < 16; ++i) { const int t = 32 * tb + (i & 3) + 8 * (i >> 2) + 4 * h; S[(cc * 64 + t) * 129 + 32 * nb + rl] = acc[i]; }
        }
    }
    __syncthreads();
    for (int repb = 0; repb < P9_REP_B; ++repb) {
        const int row = tid >> 2, qd = tid & 3;
        const LAS float* base = S + row * 129 + 32 * qd;
        unsigned x[32];
#pragma unroll
        for (int j = 0; j < 32; ++j) { const unsigned u = __float_as_uint(base[j]); const unsigned o = (u & 0x80000000u) ? ~u : (u | 0x80000000u); x[j] = (o & ~127u) | (unsigned)(127 - (32 * qd + j)); }
#define CE_DESC(a_, b_) do { const unsigned hi_ = max(x[a_], x[b_]), lo_ = min(x[a_], x[b_]); x[a_] = hi_; x[b_] = lo_; } while (0)
#pragma unroll
        for (int k = 2; k <= 16; k <<= 1)
#pragma unroll
            for (int j = k >> 1; j > 0; j >>= 1)
#pragma unroll
                for (int i = 0; i < 32; ++i) { const int l2 = i ^ j; if (l2 > i) { if ((i & k) == 0) CE_DESC(i, l2); else CE_DESC(l2, i); } }
#pragma unroll
        for (int i = 0; i < 16; ++i) x[i] = max(x[i], x[i + 16]);
#pragma unroll
        for (int j = 8; j > 0; j >>= 1)
#pragma unroll
            for (int i = 0; i < 16; ++i) { const int l2 = i ^ j; if (l2 > i) CE_DESC(i, l2); }
#define MERGE_LEVEL(ctrl_) do { \
            _Pragma("unroll") for (int i = 0; i < 16; ++i) x[16 + i] = (unsigned)__builtin_amdgcn_update_dpp(0, (int)x[i], ctrl_, 0xF, 0xF, false); \
            _Pragma("unroll") for (int i = 0; i < 16; ++i) x[i] = max(x[i], x[31 - i]); \
            _Pragma("unroll") for (int j = 8; j > 0; j >>= 1) _Pragma("unroll") for (int i = 0; i < 16; ++i) { const int l2 = i ^ j; if (l2 > i) CE_DESC(i, l2); } } while (0)
        MERGE_LEVEL(0xB1);
        MERGE_LEVEL(0x4E);
#undef MERGE_LEVEL
#undef CE_DESC
        if (qd == 0) {
#pragma unroll
            for (int k = 0; k < 16; ++k) { const int n = 127 - (int)(x[k] & 127u); SI[row * 16 + k] = n; SV[row * 16 + k] = S[row * 129 + n]; }
        }
    }
    __syncthreads();
    for (int repc = 0; repc < P9_REP_C; ++repc) if (tid < 64) {
        float a[16], c[16]; int p[16];
        const LAS float* bl = SV + (64 + tid) * 16;
        const float b0v = bl[0];
#pragma unroll
        for (int i = 0; i < 16; ++i) { a[i] = SV[tid * 16 + i]; c[i] = a[i] + b0v; p[i] = 0; }
        float fv[16]; int fi[16];
#pragma unroll
        for (int k = 0; k < 16; ++k) {
            float best = c[0]; int bi = 0;
#pragma unroll
            for (int i = 1; i < 16; ++i) if (c[i] > best) { best = c[i]; bi = i; }
            int pj = 0, lim = 16;
#pragma unroll
            for (int i = 0; i < 16; ++i) { pj = (i == bi) ? p[i] : pj; lim = (i == bi) ? 16 / (i + 1) : lim; }
            fv[k] = best; fi[k] = bi * 16 + pj;
            const int np = pj + 1; const float nb = bl[np & 15];
#pragma unroll
            for (int i = 0; i < 16; ++i) if (i == bi) { p[i] = np; c[i] = (np < lim) ? a[i] + nb : -INFINITY; }
        }
        float sum = 0.f;
        const float fmx = fv[0];
#pragma unroll
        for (int k = 0; k < 16; ++k) { fv[k] = __expf(fv[k] - fmx); sum += fv[k]; }
        const float inv = 1.0f / sum;
        int* EID = (int*)(ws + WS_EID) + (size_t)(r0 + tid) * 128 + hd * 16; float* GW = (float*)(ws + WS_GW) + (size_t)(r0 + tid) * 128 + hd * 16;
#pragma unroll
        for (int k = 0; k < 16; ++k) { const int i1 = SI[tid * 16 + (fi[k] >> 4)], i2 = SI[(64 + tid) * 16 + (fi[k] & 15)]; EID[k] = i1 * 128 + i2; GW[k] = fv[k] * inv; }
    }
    __syncthreads();
}

__device__ __forceinline__ void peer_gather(const Frame& F, int l) {
    const Args A = load_args();
    int lane = F.lane; asm volatile("" : "+v"(lane));
    __attribute__((address_space(1))) unsigned char* wsl_ = (__attribute__((address_space(1))) unsigned char*)F.ws; asm volatile("" : "+s"(wsl_)); unsigned char* ws = (unsigned char*)wsl_;
    const unsigned char* Ub = ws + WS_U + (size_t)l * NEXP * 1024; const unsigned char* Ue = ws + WS_ESC + (size_t)l * NEXP * 128;
    const unsigned char* Vb = ws + WS_V + (size_t)l * NEXP * 1024; const unsigned char* Ve = Ue + 64;
    bf16_t* XBp = (bf16_t*)(ws + WS_XB);
    const float* g2 = A.in[I_LN2G] + l * D; const float* b2 = A.in[I_LN2B] + l * D;
    for (int t = F.bid * NWAVES + F.wave; t < M; t += F.G * NWAVES) {
        asm volatile("" : "+v"(lane));
        int e0 = ((const int*)(ws + WS_EID))[(size_t)t * 128 + lane], e1 = ((const int*)(ws + WS_EID))[(size_t)t * 128 + 64 + lane];
        const float w0 = ((const float*)(ws + WS_GW))[(size_t)t * 128 + lane], w1 = ((const float*)(ws + WS_GW))[(size_t)t * 128 + 64 + lane];
        u32x4 xw4[4];
#pragma unroll
        for (int q = 0; q < 4; ++q) xw4[q] = *(const u32x4*)(XBp + (size_t)t * D + 32 * lane + 8 * q);
        asm volatile("" : "+v"(e0), "+v"(e1));
        f32x2 xp[16];
        f32x2 acc[16];
#pragma unroll
        for (int j = 0; j < 16; ++j) acc[j] = (f32x2){0.f, 0.f};
        u32x4 rr[16]; float rsc[16];
#define PG_EID(idx_) ((idx_) < 64 ? __builtin_amdgcn_readlane(e0, (idx_)) : __builtin_amdgcn_readlane(e1, (idx_) - 64))
#define PG_STEP(st_, eb_) do { const int g_ = (st_) >> 3, k_ = (st_) & 7; const int e_ = PG_EID((eb_) + 4 * g_ + (k_ & 3)); \
            if (k_ >= 4) { rr[st_] = *(const u32x4*)(Vb + (size_t)e_ * 1024 + 16 * lane); rsc[st_] = __uint_as_float((unsigned)Ve[(size_t)e_ * 128 + lane]); } \
            else { rr[st_] = *(const u32x4*)(Ub + (size_t)e_ * 1024 + 16 * lane); rsc[st_] = __uint_as_float((unsigned)Ue[(size_t)e_ * 128 + lane]); } } while (0)
#pragma unroll
        for (int s = 0; s < 15; ++s) PG_STEP(s, 0);
#pragma unroll
        for (int q = 0; q < 4; ++q) { const u32x4 w = xw4[q];
            xp[4 * q] = (f32x2){bflo(w.x), bfhi(w.x)}; xp[4 * q + 1] = (f32x2){bflo(w.y), bfhi(w.y)}; xp[4 * q + 2] = (f32x2){bflo(w.z), bfhi(w.z)}; xp[4 * q + 3] = (f32x2){bflo(w.w), bfhi(w.w)}; }
#pragma unroll 1
        for (int it = 0; it < 16; ++it) {
            const int eb = 8 * it;
            float cf[4];
#pragma unroll
            for (int s = 0; s < 16; ++s) {
                asm volatile("" ::: "memory");
                if (s == 0) PG_STEP(15, eb); else if (it < 15) PG_STEP(s - 1, eb + 8);
                asm volatile("" ::: "memory");
                const int g = s >> 3, k = s & 7;
                const float bsc = __uint_as_float(__float_as_uint(rsc[s]) << 23);
                if (k < 4) {
                    f32x2 d2 = (f32x2){0.f, 0.f};
#pragma unroll
                    for (int i = 0; i < 4; ++i) { const unsigned w = rr[s][i];
                        d2 += xp[4 * i + 0] * __builtin_amdgcn_cvt_scalef32_pk_f32_fp4(w, bsc, 0); d2 += xp[4 * i + 1] * __builtin_amdgcn_cvt_scalef32_pk_f32_fp4(w, bsc, 1);
                        d2 += xp[4 * i + 2] * __builtin_amdgcn_cvt_scalef32_pk_f32_fp4(w, bsc, 2); d2 += xp[4 * i + 3] * __builtin_amdgcn_cvt_scalef32_pk_f32_fp4(w, bsc, 3); }
                    const float act = wave_sum_dpp(d2[0] + d2[1]);
                    const int idx = eb + 4 * g + k;
                    const float gwt = __uint_as_float(idx < 64 ? __builtin_amdgcn_readlane(__float_as_uint(w0), idx) : __builtin_amdgcn_readlane(__float_as_uint(w1), idx - 64));
                    cf[k] = gwt * gelu_tanh(act);
                } else {
                    const float c1 = cf[k - 4];
#pragma unroll
                    for (int i = 0; i < 4; ++i) { const unsigned w = rr[s][i];
                        acc[4 * i + 0] += __builtin_amdgcn_cvt_scalef32_pk_f32_fp4(w, bsc, 0) * c1; acc[4 * i + 1] += __builtin_amdgcn_cvt_scalef32_pk_f32_fp4(w, bsc, 1) * c1;
                        acc[4 * i + 2] += __builtin_amdgcn_cvt_scalef32_pk_f32_fp4(w, bsc, 2) * c1; acc[4 * i + 3] += __builtin_amdgcn_cvt_scalef32_pk_f32_fp4(w, bsc, 3) * c1; }
                }
            }
        }
#undef PG_STEP
#undef PG_EID
        f32x4 g2v[8], b2v[8];
#pragma unroll
        for (int j = 0; j < 8; ++j) { g2v[j] = *(const f32x4*)(g2 + 32 * lane + 4 * j); b2v[j] = *(const f32x4*)(b2 + 32 * lane + 4 * j); }
        float s = 0.f;
#pragma unroll
        for (int j = 0; j < 16; ++j) { acc[j] = xp[j] * ALPHA + acc[j]; s += acc[j][0] + acc[j][1]; }
        const float mean = wave_sum(s) * (1.0f / D); float q2 = 0.f;
#pragma unroll
        for (int j = 0; j < 16; ++j) { acc[j] = acc[j] - mean; q2 += acc[j][0] * acc[j][0] + acc[j][1] * acc[j][1]; }
        const float rstd = 1.0f / sqrtf(wave_sum(q2) * (1.0f / D) + LN_EPS);
#pragma unroll
        for (int j = 0; j < 8; ++j) { const int cix = 32 * lane + 4 * j; const f32x4 gg = g2v[j], bb = b2v[j];
            const f32x4 av = (f32x4){acc[2 * j][0], acc[2 * j][1], acc[2 * j + 1][0], acc[2 * j + 1][1]};
            const f32x4 y = av * rstd * gg + bb;
            if (l == 1) *(f32x4*)(A.out + O_YP + (size_t)t * D + cix) = y; else { *(u32x2*)(XBp + (size_t)t * D + cix) = (u32x2){pk2(y[0], y[1]), pk2(y[2], y[3])}; *(unsigned*)(ws + WS_XB8 + (size_t)t * D + cix) = pk4_fp8(y); } }
    }
}
constexpr int NPHASES = 21;
template <unsigned MASK> __global__ void __launch_bounds__(NTHREADS, 2) fwd(Args A0) {
    extern __shared__ __attribute__((aligned(16))) unsigned char lds_raw[];
    Frame F0; F0.lds = (LAS unsigned char*)lds_raw; F0.ws = A0.ws; F0.ctl = (unsigned*)(A0.ws + WS_CTL);
    F0.tid = 0; F0.lane = 0; F0.wave = __builtin_amdgcn_readfirstlane((int)threadIdx.x >> 6); F0.G = gridDim.x; F0.bid = blockIdx.x;
    const Frame& F = F0;
#define PHASE_FRAME Frame F = F0; __attribute__((address_space(1))) unsigned char* w_ = (__attribute__((address_space(1))) unsigned char*)F0.ws; asm volatile("" : "+s"(w_), "+s"(F.bid), "+s"(F.G), "+s"(F.wave)); F.lane = fresh_lane(); F.tid = F.wave * 64 + F.lane; F.ws = (unsigned char*)w_; F.ctl = (unsigned*)(F.ws + WS_CTL); unsigned char* ws = F.ws; int l = l0_; asm volatile("" : "+s"(l))
    if (threadIdx.x < 64) ((LAS unsigned*)(F.lds + LDS_MISC))[threadIdx.x] = 0u;
    __syncthreads();
    const int lo = (MASK == 0x7ffu) ? 0 : A0.ph_lo, hi = (MASK == 0x7ffu) ? NPHASES : A0.ph_hi;
    const bool multi = (hi - lo) > 1;
    XcdBarrier bar; bar.bar = F.ctl + CW_BAR; bar.x = 0; bar.st = (volatile LAS unsigned*)(F.lds + LDS_MISC);
    if (multi) { bar = xcd_barrier_post(F.ctl + CW_BAR, (volatile LAS unsigned*)(F.lds + LDS_MISC)); xcd_barrier_census(bar); }
#define IN(k) (lo <= (k) && (k) < hi)
#define HAS(j) ((MASK >> (j)) & 1u)
#ifndef DUP_MASK
#define DUP_MASK 0u
#endif
#ifndef SUBDUP
#define SUBDUP 0u
#endif
#define SUBREP(b) (((SUBDUP >> (b)) & 1u) ? 2 : 1)
#define NREP(j) (((DUP_MASK >> (j)) & 1u) ? 2 : 1)
#define SEAM(k) do { if (IN(k) && IN((k) + 1)) xcd_barrier(bar); } while (0)

    if constexpr (HAS(0)) { if (IN(0)) { for (int rep = 0; rep < NREP(0); ++rep) { const int l0_ = 0; PHASE_FRAME; (void)l; p0_prologue(F); SEAM(0); } } }

    for (int l0_ = 0; l0_ < 2; ++l0_) {
        const int base = 1 + 10 * l0_;
        if constexpr (HAS(1)) if (IN(base + 0)) for (int rep = 0; rep < NREP(1); ++rep) {
            {
                PHASE_FRAME; (void)l;
                __syncthreads();
                pg8::Gemm g8{(const bf16_t*)(ws + WS_XB8), (const bf16_t*)(ws + WS_WIN8 + (size_t)l * 8192 * D), D / 2, D / 2, D / 2};
                pg8::StaticOrder S8; S8.init(M / 256, 32, F.G, F.bid, D / 2, D / 2);
                EpiGates E8{ws};
                pg8::gemm_phase<EpiGates, pg8::StaticOrder, true, true>(F.lds, g8, S8, E8, F.wave);
            }
            PHASE_FRAME; const int cwb = CW_ITEM + 64 * 8 * l + 1024 * rep; (void)cwb;
            __syncthreads();
            const Args A = load_args();
            EpiWin E{ws, A.out, l};
            pg8::Gemm g{(const bf16_t*)(ws + WS_XB), (const bf16_t*)(ws + WS_WIN) + (size_t)l * NPAD * D, D, D, D};
            pg8::StaticOrder S; S.init(M / 256, NT_BF, F.G, F.bid, D, D);
            pg8::gemm_phase<EpiWin, pg8::StaticOrder, true>(F.lds, g, S, E, F.wave);
            { const int nfull = (M / 256) * NT_BF - ((M / 256) * NT_BF / F.G) * F.G;
              if (nfull == 0 || F.bid >= nfull) { Frame Fv = F; if (nfull > 0) { Fv.bid = F.bid - nfull; Fv.G = F.G - nfull; } prep_b(Fv, l); } }
            SEAM(base + 0);
        }
        if constexpr (HAS(2)) if (IN(base + 1)) for (int rep = 0; rep < NREP(2); ++rep) {
            PHASE_FRAME; const int cwb = CW_ITEM + 64 * 8 * l + 1024 * rep; (void)cwb;
#ifndef NO_SEL
            for (int sr = 0; sr < SUBREP(0); ++sr) { for (int u = q_block(F, cwb + 0 + 2048 * sr); u < (1024 + 160); u = q_block(F, cwb + 0 + 2048 * sr)) {
                if (sr > 0) continue;
                if (u < 1024) { const int b = u >> 9, c = 63 - ((u >> 3) & 63), kc = u & 7; if (c >= 4 && kc < sel_nchunks(0, c)) score_item(F, l, 0, b, c, kc); }
                else { const int v = u - 1024; score_item(F, l, 1, v / 5, 0, v % 5); } } }
#endif
#ifndef NO_CONF
            for (int sr = 0; sr < SUBREP(1); ++sr) { for (int u = q_block(F, cwb + 64 + 2048 * sr); u < (M / 32); u = q_block(F, cwb + 64 + 2048 * sr)) { conf_unit(F, l, u); } }
#endif
#ifndef NO_POOL
            for (int sr = 0; sr < SUBREP(2); ++sr) { for (int u = q_block(F, cwb + 128 + 2048 * sr); u < (M / 64); u = q_block(F, cwb + 128 + 2048 * sr)) { pool_unit(F, l, u); } }
#endif
#ifndef NO_LRUX
            for (int sr = 0; sr < SUBREP(3); ++sr) { for (int u = q_block(F, cwb + 192 + 2048 * sr); u < (512); u = q_block(F, cwb + 192 + 2048 * sr)) { const int b = u >> 8, c = (u >> 2) & 63, nn = u & 3;
                lru_pair<false>(F, l, 0, b, c, 4 * nn); lru_pair<false>(F, l, 0, b, c, 4 * nn + 2); } }
#endif
#ifndef NO_SEL
            { for (int u = q_block(F, cwb + 448); u < (640); u = q_block(F, cwb + 448)) { const int uid = u >> 2, qg = u & 3;
                if (uid < 128) select_item(F, l, 0, uid >> 6, 63 - (uid & 63), qg); else select_item(F, l, 1, uid - 128, 0, qg); } }
#endif
            SEAM(base + 1);
        }
        if constexpr (HAS(3)) if (IN(base + 2)) for (int rep = 0; rep < NREP(3); ++rep) {
            PHASE_FRAME; const int cwb = CW_ITEM + 64 * 8 * l + 1024 * rep; (void)cwb;
            __syncthreads();
            {
                pg8::Gemm g{(const bf16_t*)(ws + WS_DIFF), (const bf16_t*)(ws + WS_POOLT) + (size_t)l * 4 * 256 * 256, WL, 256, 256};
                PoolOrder S{F.G, F.bid};
                const Args A = load_args();
                EpiPool E{ws + WS_Y + (size_t)3 * M * WL, A.in[I_PSC] + l * WL};
                for (int sr = 0; sr < SUBREP(6); ++sr) { __syncthreads(); pg8::gemm_phase<EpiPool, PoolOrder, true>(F.lds, g, S, E, F.wave); }
            }
#ifndef NO_ATT
            for (int sr = 0; sr < SUBREP(4); ++sr) { for (int u = q_block(F, cwb + 256 + 2048 * sr); u < (320); u = q_block(F, cwb + 256 + 2048 * sr)) {
                int samp, b, c, g;
                if (u < 124) { samp = 0; c = 63 - (u >> 2); b = (u >> 1) & 1; g = u & 1; } else if (u < 188) { const int v = u - 124; samp = 1; b = v >> 1; g = v & 1; c = 0; }
                else { const int v = u - 188; samp = 0; c = 32 - (v >> 2); b = (v >> 1) & 1; g = v & 1; }
                attn_unit(F, l, samp, b, c, g); } }
#endif
#ifndef NO_LRUY
            for (int sr = 0; sr < SUBREP(5); ++sr) { for (int u = q_block(F, cwb + 320 + 2048 * sr); u < (640); u = q_block(F, cwb + 320 + 2048 * sr)) {
                int samp, b, c, nn; if (u < 512) { samp = 0; b = u >> 8; c = (u >> 2) & 63; nn = u & 3; } else { const int v = u - 512; samp = 1; b = v >> 2; c = 0; nn = v & 3; }
                lru_pair<true>(F, l, samp, b, c, 4 * nn); lru_pair<true>(F, l, samp, b, c, 4 * nn + 2); } }
#endif
            SEAM(base + 2);
        }
        if constexpr (HAS(4)) if (IN(base + 3)) for (int rep = 0; rep < NREP(4); ++rep) {
            PHASE_FRAME; const int cwb = CW_ITEM + 64 * 8 * l + 1024 * rep; (void)cwb;
            __syncthreads();
            pg8::Gemm g{(const bf16_t*)(ws + WS_Y), (const bf16_t*)(ws + WS_WBR + (size_t)l * 4 * D * WL), WL / 2, WL / 2, WL / 2};
            BranchOrder S{F.G, F.bid};
            EpiGate E{(bf16_t*)(ws + WS_PG), ws + WS_GATES};
            pg8::gemm_phase<EpiGate, BranchOrder, true, true>(F.lds, g, S, E, F.wave);
            SEAM(base + 3);
        }
        if constexpr (HAS(5)) if (IN(base + 4)) for (int rep = 0; rep < NREP(5); ++rep) {
            PHASE_FRAME; const int cwb = CW_ITEM + 64 * 8 * l + 1024 * rep; (void)cwb;
            const bf16_t* PG = (const bf16_t*)(ws + WS_PG); bf16_t* Gm = (bf16_t*)(ws + WS_G);
            const size_t n8 = (size_t)M * D / 8, stride = (size_t)F.G * NTHREADS;
            for (size_t i = (size_t)F.bid * NTHREADS + F.tid; i < n8; i += stride) {
                f32x4 lo4 = (f32x4){0.f, 0.f, 0.f, 0.f}, hi4 = lo4;
#pragma unroll
                for (int z = 0; z < 4; ++z) { const u32x4 w = *(const u32x4*)(PG + (size_t)z * M * D + 8 * i);
                    lo4[0] += bflo(w.x); lo4[1] += bfhi(w.x); lo4[2] += bflo(w.y); lo4[3] += bfhi(w.y); hi4[0] += bflo(w.z); hi4[1] += bfhi(w.z); hi4[2] += bflo(w.w); hi4[3] += bfhi(w.w); }
                u32x4 o; o.x = pk2(lo4[0], lo4[1]); o.y = pk2(lo4[2], lo4[3]); o.z = pk2(hi4[0], hi4[1]); o.w = pk2(hi4[2], hi4[3]);
                *(u32x4*)(Gm + 8 * i) = o; }
            SEAM(base + 4);
        }
        if constexpr (HAS(6)) if (IN(base + 5)) for (int rep = 0; rep < NREP(6); ++rep) {
            PHASE_FRAME; const int cwb = CW_ITEM + 64 * 8 * l + 1024 * rep; (void)cwb;
            __syncthreads();
            pg8::Gemm g{(const bf16_t*)(ws + WS_G), (const bf16_t*)(ws + WS_WOUT) + (size_t)l * D * D, D, D, D};
            pg8::StaticOrder S; S.init(M / 256, D / 256, F.G, F.bid, D, D);
            const Args A = load_args();
            EpiOut E{A.in[I_XP], A.in[I_XS], (l == 0) ? (const bf16_t*)nullptr : (const bf16_t*)(ws + WS_XB), (bf16_t*)(ws + WS_PRE1)};
            pg8::gemm_phase<EpiOut, pg8::StaticOrder, true>(F.lds, g, S, E, F.wave);
            { const int nfull = (M / 256) * (D / 256) - ((M / 256) * (D / 256) / F.G) * F.G;
              if (nfull == 0 || F.bid >= nfull) { Frame Fv = F; if (nfull > 0) { Fv.bid = F.bid - nfull; Fv.G = F.G - nfull; } prep_u(Fv, l); if (l == 0) prep_a_bf(Fv, 1); } }
            SEAM(base + 5);
        }
        if constexpr (HAS(7)) if (IN(base + 6)) for (int rep = 0; rep < NREP(7); ++rep) {
            PHASE_FRAME; const int cwb = CW_ITEM + 64 * 8 * l + 1024 * rep; (void)cwb;
            const bf16_t* PRE = (const bf16_t*)(ws + WS_PRE1); bf16_t* XB = (bf16_t*)(ws + WS_XB);
            const Args A = load_args();
            const float* g1 = A.in[I_LN1G] + l * D; const float* b1 = A.in[I_LN1B] + l * D; const int lane = F.lane;
            f32x4 g1v[8], b1v[8];
#pragma unroll
            for (int j = 0; j < 4; ++j) { const int cix = 512 * j + 8 * lane; g1v[2 * j] = *(const f32x4*)(g1 + cix); g1v[2 * j + 1] = *(const f32x4*)(g1 + cix + 4); b1v[2 * j] = *(const f32x4*)(b1 + cix); b1v[2 * j + 1] = *(const f32x4*)(b1 + cix + 4); }
            for (int r = F.bid * NWAVES + F.wave; r < M; r += F.G * NWAVES) {
                f32x4 v[8]; float s = 0.f;
                u32x4 pw[4];
#pragma unroll
                for (int j = 0; j < 4; ++j) pw[j] = *(const u32x4*)(PRE + (size_t)r * D + 512 * j + 8 * lane);
                asm volatile("" : "+v"(pw[0]), "+v"(pw[1]), "+v"(pw[2]), "+v"(pw[3]));
#pragma unroll
                for (int j = 0; j < 4; ++j) { const u32x4 w = pw[j];
                    v[2 * j] = (f32x4){bflo(w.x), bfhi(w.x), bflo(w.y), bfhi(w.y)}; v[2 * j + 1] = (f32x4){bflo(w.z), bfhi(w.z), bflo(w.w), bfhi(w.w)};
                    s += ((v[2 * j][0] + v[2 * j][1]) + (v[2 * j][2] + v[2 * j][3])) + ((v[2 * j + 1][0] + v[2 * j + 1][1]) + (v[2 * j + 1][2] + v[2 * j + 1][3])); }
                const float mean = wave_sum(s) * (1.0f / D); float q = 0.f;
#pragma unroll
                for (int j = 0; j < 8; ++j) { v[j] = v[j] - mean; q += (v[j][0] * v[j][0] + v[j][1] * v[j][1]) + (v[j][2] * v[j][2] + v[j][3] * v[j][3]); }
                const float rstd = 1.0f / sqrtf(wave_sum(q) * (1.0f / D) + LN_EPS);
#pragma unroll
                for (int j = 0; j < 4; ++j) { const int cix = 512 * j + 8 * lane;
                    const f32x4 y0 = v[2 * j] * rstd * g1v[2 * j] + b1v[2 * j], y1 = v[2 * j + 1] * rstd * g1v[2 * j + 1] + b1v[2 * j + 1];
                    *(u32x4*)(XB + (size_t)r * D + cix) = (u32x4){pk2(y0[0], y0[1]), pk2(y0[2], y0[3]), pk2(y1[0], y1[1]), pk2(y1[2], y1[3])}; }
            }
            SEAM(base + 6);
        }
        if constexpr (HAS(8)) if (IN(base + 7)) for (int rep = 0; rep < NREP(8); ++rep) {
            PHASE_FRAME; const int cwb = CW_ITEM + 64 * 8 * l + 1024 * rep; (void)cwb;
            __syncthreads();
            pg8::Gemm g{(const bf16_t*)(ws + WS_XB), (const bf16_t*)(ws + WS_WQ) + (size_t)l * D * D, D, D, D};
            pg8::StaticOrder S; S.init(M / 256, D / 256, F.G, F.bid, D, D);
            EpiQ E{(bf16_t*)(ws + WS_QP)};
            pg8::gemm_phase<EpiQ, pg8::StaticOrder, true>(F.lds, g, S, E, F.wave);
            { const int nfull = (M / 256) * (D / 256) - ((M / 256) * (D / 256) / F.G) * F.G;
              if (nfull == 0 || F.bid >= nfull) { Frame Fv = F; if (nfull > 0) { Fv.bid = F.bid - nfull; Fv.G = F.G - nfull; } prep_c(Fv, l); if (l == 0) prep_a_f8(Fv, 1); } }
            SEAM(base + 7);
        }
        if constexpr (HAS(9)) if (IN(base + 8)) for (int rep = 0; rep < NREP(9); ++rep) {
            PHASE_FRAME; const int cwb = CW_ITEM + 64 * 8 * l + 1024 * rep; (void)cwb;
            { for (int u = q_block(F, cwb + 384); u < ((M / 64) * 8); u = q_block(F, cwb + 384)) { peer_score_unit(F, l, u); } }
            SEAM(base + 8);
        }
        if constexpr (HAS(10)) if (IN(base + 9)) for (int rep = 0; rep < ((l0_ == 1) ? NREP(10) : 1); ++rep) {
            PHASE_FRAME; const int cwb = CW_ITEM + 64 * 8 * l + 1024 * rep; (void)cwb;
            peer_gather(F, l);
            SEAM(base + 9);
        }
    }
#undef IN
#undef SEAM
#undef HAS
#undef NREP
#undef PHASE_FRAME
}

#ifndef N_SPLIT
#define N_SPLIT 1
#endif
template <unsigned MASK> static bool setup_kernel() { return hipFuncSetAttribute((const void*)fwd<MASK>, hipFuncAttributeMaxDynamicSharedMemorySize, LDS_BYTES) == hipSuccess; }
template <unsigned MASK> static void launch_kernel(int grid, hipStream_t stream, const Args& a) { hipLaunchKernelGGL(fwd<MASK>, dim3(grid), dim3(NTHREADS), LDS_BYTES, stream, a); }
extern "C" void kernel_launch(void* const* d_in, const int* in_sizes, int n_in, void* d_out, int out_size, void* d_ws, size_t ws_size, hipStream_t stream) {
    static int grid = 0;
    if (grid == 0) {
        if (n_in != 33 || (size_t)out_size != O_END || ws_size < WS_END) { fprintf(stderr, "kernel_launch: unexpected shapes (n_in %d out %d ws %zu need %zu)\n", n_in, out_size, ws_size, (size_t)WS_END); grid = -1; return; }
        int dev = 0, cus = 0;
        if (hipGetDevice(&dev) != hipSuccess || hipDeviceGetAttribute(&cus, hipDeviceAttributeMultiprocessorCount, dev) != hipSuccess) { grid = -1; return; }
        bool ok = true;
#if N_SPLIT == 1
        ok = setup_kernel<0x7ffu>();
#else
        ok = setup_kernel<1u>() && setup_kernel<2u>() && setup_kernel<4u>() && setup_kernel<8u>() && setup_kernel<16u>() && setup_kernel<32u>() && setup_kernel<64u>() && setup_kernel<128u>() && setup_kernel<256u>() && setup_kernel<512u>() && setup_kernel<1024u>();
#endif
        if (!ok) { fprintf(stderr, "kernel_launch: hipFuncSetAttribute failed\n"); grid = -1; return; }
        (void)hipGetLastError();
        grid = cus;
    }
    if (grid < 0) return;
    (void)hipMemsetAsync((char*)d_ws + WS_CTL, 0, CTL_BYTES, stream);
    Args a{};
    for (int i = 0; i < 33; ++i) a.in[i] = (const float*)d_in[i];
    a.out = (float*)d_out; a.ws = (unsigned char*)d_ws;
#if N_SPLIT == 1
    a.ph_lo = 0; a.ph_hi = NPHASES; launch_kernel<0x7ffu>(grid, stream, a);
#else
    for (int p = 0; p < NPHASES; ++p) { a.ph_lo = p; a.ph_hi = p + 1; const int j = (p == 0) ? 0 : 1 + (p - 1) % 10;
        switch (j) { case 0: launch_kernel<1u>(grid, stream, a); break; case 1: launch_kernel<2u>(grid, stream, a); break; case 2: launch_kernel<4u>(grid, stream, a); break; case 3: launch_kernel<8u>(grid, stream, a); break;
            case 4: launch_kernel<16u>(grid, stream, a); break; case 5: launch_kernel<32u>(grid, stream, a); break; case 6: launch_kernel<64u>(grid, stream, a); break; case 7: launch_kernel<128u>(grid, stream, a); break;
            case 8: launch_kernel<256u>(grid, stream, a); break; case 9: launch_kernel<512u>(grid, stream, a); break; default: launch_kernel<1024u>(grid, stream, a); break; } }
#endif
}
```
